# Optimizing an MI355X kernel written in HIP

```python
import jax, jax.numpy as jnp
from jax import lax
import numpy as np

D_MODEL = 1024
BATCH = 16
SEQ = 4096
DEPTH = 4

N_META = 16
D_MIX = 1024
FOURIER_HEADS = 4
FOURIER_HEAD_DIM = 64
D_FOURIER = FOURIER_HEADS * FOURIER_HEAD_DIM
POOL_WINDOWS = (2, 4, 8, 16)
N_POOL_GROUPS = 4
POOL_GROUP_DIM = 64
D_POOL = N_POOL_GROUPS * POOL_GROUP_DIM
MLA_HEADS = 4
QK_NOPE_DIM = 128
QK_ROPE_DIM = 64
V_HEAD_DIM = 128
D_ATTN = MLA_HEADS * V_HEAD_DIM
Q_LORA_RANK = 384
KV_LORA_RANK = 256
ROPE_THETA = 10000.0
QUERY_BLOCK = 128
NORM_EPS = 1e-6
IN_SIZES = (D_FOURIER, D_FOURIER, D_POOL, D_POOL, Q_LORA_RANK, KV_LORA_RANK, QK_ROPE_DIM, D_ATTN)
D_IN = 2 * D_FOURIER + 2 * D_POOL + Q_LORA_RANK + KV_LORA_RANK + QK_ROPE_DIM + D_ATTN

kernel_name = "hymba_fnet_pool_mla_encoder"


def rms_norm(x, w):
    xf = x.astype(jnp.float32)
    y = xf * lax.rsqrt(jnp.mean(xf * xf, axis=-1, keepdims=True) + NORM_EPS)
    return (y * w.astype(jnp.float32)).astype(x.dtype)


def rope_tables(length):
    inv = 1.0 / (ROPE_THETA ** (jnp.arange(0, QK_ROPE_DIM, 2, dtype=jnp.float32) / QK_ROPE_DIM))
    ang = jnp.arange(length, dtype=jnp.float32)[:, None] * inv[None, :]
    return jnp.cos(ang), jnp.sin(ang)


def apply_rope(t, cos, sin):
    tf = t.astype(jnp.float32)
    half = QK_ROPE_DIM // 2
    t1, t2 = tf[..., :half], tf[..., half:]
    out = jnp.concatenate([t1 * cos - t2 * sin, t2 * cos + t1 * sin], axis=-1)
    return out.astype(t.dtype)


def fourier_mix(f_in, fourier_w):
    B, L, _ = f_in.shape
    xf = f_in.reshape(B, L, FOURIER_HEADS, FOURIER_HEAD_DIM).astype(jnp.float32)
    y = jnp.fft.fft2(xf, axes=(1, 3), norm="ortho").real.astype(f_in.dtype)
    y = jnp.einsum('blhc,hcd->blhd', y, fourier_w)
    return y.reshape(B, L, D_FOURIER)


def pool_mix(p_in, pool_w, pool_scale):
    B, L, _ = p_in.shape
    xg = p_in.reshape(B, L, N_POOL_GROUPS, POOL_GROUP_DIM).astype(jnp.float32)
    cs = jnp.concatenate([jnp.zeros((B, 1, N_POOL_GROUPS, POOL_GROUP_DIM), jnp.float32),
                          jnp.cumsum(xg, axis=1)], axis=1)
    idx = jnp.arange(L)
    outs = []
    for g, w in enumerate(POOL_WINDOWS):
        lo = jnp.clip(idx - w // 2, 0, L)
        hi = jnp.clip(idx + w // 2, 0, L)
        s = cs[:, hi, g] - cs[:, lo, g]
        cnt = (hi - lo).astype(jnp.float32)[None, :, None]
        outs.append(s / cnt - xg[:, :, g])
    y = jnp.stack(outs, axis=2).astype(p_in.dtype)
    y = jnp.einsum('blgc,gcd->blgd', y, pool_w).reshape(B, L, D_POOL)
    return y * pool_scale


def mla_mix(c_q, c_kv, k_r, q_norm_w, w_uq, kv_norm_w, w_ukv, cos, sin):
    B, L, _ = c_q.shape
    dq = QK_NOPE_DIM + QK_ROPE_DIM
    q = (rms_norm(c_q, q_norm_w) @ w_uq).reshape(B, L, MLA_HEADS, dq)
    q = jnp.concatenate([q[..., :QK_NOPE_DIM],
                         apply_rope(q[..., QK_NOPE_DIM:], cos[None, :, None], sin[None, :, None])], axis=-1)
    kv = (rms_norm(c_kv, kv_norm_w) @ w_ukv).reshape(B, L, MLA_HEADS, QK_NOPE_DIM + V_HEAD_DIM)
    k_nope, v = kv[..., :QK_NOPE_DIM], kv[..., QK_NOPE_DIM:]
    k_rope = apply_rope(k_r, cos[None], sin[None])
    k = jnp.concatenate([k_nope, jnp.broadcast_to(k_rope[:, :, None, :], (B, L, MLA_HEADS, QK_ROPE_DIM))], axis=-1)
    scale = dq ** -0.5

    def attend(qb):
        s = jnp.einsum('bqhd,bkhd->bhqk', qb, k).astype(jnp.float32) * scale
        p = jax.nn.softmax(s, axis=-1).astype(v.dtype)
        return jnp.einsum('bhqk,bkhd->bqhd', p, v)

    o_meta = attend(q[:, :N_META])
    n_blk = (L - N_META) // QUERY_BLOCK
    qb = jnp.moveaxis(q[:, N_META:].reshape(B, n_blk, QUERY_BLOCK, MLA_HEADS, dq), 1, 0)
    o = lax.map(attend, qb)
    o = jnp.moveaxis(o, 0, 1).reshape(B, L - N_META, MLA_HEADS, V_HEAD_DIM)
    return jnp.concatenate([o_meta, o], axis=1).reshape(B, L, D_ATTN)


def setup_inputs(seed: int = 0) -> dict:
    key = jax.random.key(seed)
    ks = jax.random.split(key, 13)
    f32 = jnp.float32
    nrm = lambda k, shape, fan: jax.random.normal(k, shape, f32) * (fan ** -0.5)
    return {
        "x": jax.random.normal(ks[0], (BATCH, SEQ, D_MODEL), f32),
        "meta_tokens": jax.random.normal(ks[1], (N_META, D_MODEL), f32),
        "norm_w": 1.0 + 0.02 * jax.random.normal(ks[2], (DEPTH, D_MODEL), f32),
        "w_in": nrm(ks[3], (DEPTH, D_MODEL, D_IN), D_MODEL),
        "fourier_w": nrm(ks[4], (DEPTH, FOURIER_HEADS, FOURIER_HEAD_DIM, FOURIER_HEAD_DIM), FOURIER_HEAD_DIM),
        "pool_w": nrm(ks[5], (DEPTH, N_POOL_GROUPS, POOL_GROUP_DIM, POOL_GROUP_DIM), POOL_GROUP_DIM),
        "pool_scale": 1.0 + 0.02 * jax.random.normal(ks[6], (DEPTH, D_POOL), f32),
        "q_norm_w": 1.0 + 0.02 * jax.random.normal(ks[7], (DEPTH, Q_LORA_RANK), f32),
        "w_uq": nrm(ks[8], (DEPTH, Q_LORA_RANK, MLA_HEADS * (QK_NOPE_DIM + QK_ROPE_DIM)), Q_LORA_RANK),
        "kv_norm_w": 1.0 + 0.02 * jax.random.normal(ks[9], (DEPTH, KV_LORA_RANK), f32),
        "w_ukv": nrm(ks[10], (DEPTH, KV_LORA_RANK, MLA_HEADS * (QK_NOPE_DIM + V_HEAD_DIM)), KV_LORA_RANK),
        "w_out": nrm(ks[11], (DEPTH, D_MIX, D_MODEL), D_MIX),
        "final_norm_w": 1.0 + 0.02 * jax.random.normal(ks[12], (D_MODEL,), f32),
    }


def reference(x, meta_tokens, norm_w, w_in, fourier_w, pool_w, pool_scale, q_norm_w, w_uq,
              kv_norm_w, w_ukv, w_out, final_norm_w):
    B = x.shape[0]
    h = jnp.concatenate([jnp.broadcast_to(meta_tokens[None].astype(x.dtype), (B, N_META, D_MODEL)), x], axis=1)
    L = h.shape[1]
    cos, sin = rope_tables(L)
    split_idx = np.cumsum(IN_SIZES)[:-1].tolist()
    for l in range(DEPTH):
        u = rms_norm(h, norm_w[l]) @ w_in[l]
        f_in, f_gate, p_in, p_gate, c_q, c_kv, k_r, a_gate = jnp.split(u, split_idx, axis=-1)
        y_f = fourier_mix(f_in, fourier_w[l])
        y_p = pool_mix(p_in, pool_w[l], pool_scale[l])
        y_a = mla_mix(c_q, c_kv, k_r, q_norm_w[l], w_uq[l], kv_norm_w[l], w_ukv[l], cos, sin)
        mix = jnp.concatenate([y_f * jax.nn.silu(f_gate),
                               y_p * jax.nn.silu(p_gate),
                               y_a * jax.nn.silu(a_gate)], axis=-1)
        h = h + mix @ w_out[l]
    return rms_norm(h, final_norm_w)[:, N_META:]
```

```cpp
#include <hip/hip_runtime.h>
#include <hip/hip_cooperative_groups.h>
#include <cstdio>
#include <cstdint>
namespace cg = cooperative_groups;

#define LAS __attribute__((address_space(3)))
typedef unsigned short bf16_t;
typedef short bf16x8 __attribute__((ext_vector_type(8)));
typedef short s16x4 __attribute__((ext_vector_type(4)));
typedef float f32x4 __attribute__((ext_vector_type(4)));
typedef float f32x8 __attribute__((ext_vector_type(8)));
typedef float f32x16 __attribute__((ext_vector_type(16)));
typedef unsigned u32x4 __attribute__((ext_vector_type(4)));
typedef unsigned u32x2 __attribute__((ext_vector_type(2)));

constexpr int DM = 1024, NB = 16, SEQ = 4096, NMETA = 16, L = SEQ + NMETA, MTOK = NB * L, DEPTH = 4;
constexpr int DIN = 2240, UW = 2048;
constexpr int LP = 4224, KD = 2 * LP;
constexpr int LH = L / 2, LF = 2176, KF = 2 * LF;
constexpr int QW = 768, KVW = 1024;
constexpr float NORM_EPS = 1e-6f;
constexpr int U_CQ = 0, U_KR = 384, U_CKV = 512, U_FG = 768, U_PP = 1024, U_PG = 1280, U_AG = 1536;

constexpr size_t al256(size_t x) { return (x + 255) / 256 * 256; }
constexpr size_t WS_H = 0;
constexpr size_t WS_RH = WS_H + al256((size_t)MTOK * DM * 2);
constexpr size_t WS_HN = WS_RH + al256((size_t)MTOK * 4);
constexpr size_t WS_U = WS_HN + al256((size_t)MTOK * DM * 2);
constexpr size_t WS_XT = WS_U + al256((size_t)MTOK * UW * 2);
constexpr size_t WS_DFT = WS_XT + al256((size_t)4096 * KD * 2);
constexpr size_t WS_Q = WS_DFT + al256((size_t)L * KF * 2);
constexpr size_t WS_KV = WS_Q + al256((size_t)MTOK * QW * 2);
constexpr size_t WS_WN = WS_KV + al256((size_t)MTOK * KVW * 2);
constexpr size_t WS_WF = WS_WN + al256((size_t)UW * DM * 2);
constexpr size_t WS_WQ = WS_WF + al256((size_t)512 * DM * 2);
constexpr size_t WS_WKV = WS_WQ + al256((size_t)768 * 384 * 2);
constexpr size_t WS_WO = WS_WKV + al256((size_t)1024 * 256 * 2);
constexpr size_t WS_RQ = WS_WO + al256((size_t)1024 * 1024 * 2);
constexpr size_t WS_RKV = WS_RQ + al256((size_t)MTOK * 4);
constexpr size_t WS_COS = WS_RKV + al256((size_t)MTOK * 4);
constexpr size_t WS_SIN = WS_COS + al256((size_t)L * 32 * 4);
constexpr size_t WS_CWF = WS_SIN + al256((size_t)L * 32 * 4);
constexpr size_t WS_SWF = WS_CWF + al256((size_t)DEPTH * 4 * 64 * 64 * 4);
constexpr size_t WS_PART = WS_SWF + al256((size_t)DEPTH * 4 * 64 * 64 * 4);
constexpr int PART_STRIDE = 16 * 128 + 32;
constexpr size_t WS_BAR = WS_PART + al256((size_t)256 * PART_STRIDE * 4);
constexpr size_t WS_END = WS_BAR + al256((size_t)3456 * 4);

constexpr int LDS_BYTES = 131072 + 4096 + 64;

__device__ __forceinline__ unsigned cvt_pk_bf16(float lo, float hi) { unsigned r; asm volatile("v_cvt_pk_bf16_f32 %0, %1, %2" : "=v"(r) : "v"(lo), "v"(hi)); return r; }
__device__ __forceinline__ int opaque_tid_w(int wave_s) { int t; asm volatile("v_mbcnt_lo_u32_b32 %0, -1, 0\n\tv_mbcnt_hi_u32_b32 %0, -1, %0" : "=&v"(t)); return (wave_s << 6) | t; }
__device__ __forceinline__ float opaque_zero() { float z; asm volatile("v_mov_b32 %0, 0" : "=v"(z)); return z; }
__device__ __forceinline__ float bf_lo(unsigned w) { return __uint_as_float(w << 16); }
__device__ __forceinline__ float bf_hi(unsigned w) { return __uint_as_float(w & 0xffff0000u); }
__device__ __forceinline__ float bf1(bf16_t x) { return __uint_as_float((unsigned)x << 16); }
__device__ __forceinline__ float wave_sum_l(float v, int lane) {
#pragma unroll
    for (int o = 1; o < 64; o <<= 1) v += __uint_as_float((unsigned)__builtin_amdgcn_ds_bpermute((lane ^ o) << 2, (int)__float_as_uint(v)));
    return v;
}
#define wave_sum(v) wave_sum_l((v), lane)
__device__ __forceinline__ float silu_f(float x) { return x * __builtin_amdgcn_rcpf(1.f + __expf(-x)); }
__device__ __forceinline__ u32x4 pack8(f32x4 a, f32x4 b) { u32x4 w; w.x = cvt_pk_bf16(a[0], a[1]); w.y = cvt_pk_bf16(a[2], a[3]); w.z = cvt_pk_bf16(b[0], b[1]); w.w = cvt_pk_bf16(b[2], b[3]); return w; }
__device__ __forceinline__ int rope_src(int jj) { const int g = jj >> 3, e = jj & 7; return e < 4 ? 4 * g + e : 28 + 4 * g + e; }

namespace pg8 {
constexpr int BM = 256, BK = 64, HALF = 128, HTB = HALF * BK * 2, NXCD = 8, WGM = 8;
__host__ __device__ __forceinline__ int lds_byte(int r, int c) { const int st = (r >> 4) * 2 + (c >> 5), rr = r & 15, cc = c & 31, ob = rr * 64 + cc * 2; return st * 1024 + (ob ^ (((ob >> 9) & 1) << 5)); }
__host__ __device__ __forceinline__ void stage_rc(int b, int& R, int& C) { const int st = b / 1024, sb = b % 1024, swz = sb ^ (((sb >> 9) & 1) << 5); R = (st >> 1) * 16 + swz / 64; C = (st & 1) * 32 + (swz % 64) / 2; }
__host__ __device__ __forceinline__ int perm32(int rho) { const int n = rho >> 4, i = rho & 15; return 8 * (i >> 2) + 4 * n + (i & 3); }
struct Unit { int pm, pn; };
struct Gemm { const bf16_t* A; const bf16_t* Bt; int M, N, K, lda, ldb; };
struct StaticOrder {
    int nM, nN, nwg, G, c;
    __device__ void init(int M, int N, int G_, int c_) { nM = M / BM; nN = N / BM; nwg = nM * nN; G = G_; c = c_; }
    __device__ bool next(int i, Unit& u) const {
        const long Lx = (long)i * G + c; if (Lx >= nwg) return false;
        int wgid = (int)Lx; { const int q = nwg / NXCD, r = nwg % NXCD, xcd = wgid % NXCD, off = wgid / NXCD; wgid = (xcd < r ? xcd * (q + 1) : r * (q + 1) + (xcd - r) * q) + off; }
        const int nig = WGM * nN, gid = wgid / nig, fm = gid * WGM, gsz = (nM - fm) < WGM ? (nM - fm) : WGM;
        u.pm = fm + ((wgid % nig) % gsz); u.pn = (wgid % nig) / gsz; return true;
    }
};
template <class Epi>
__device__ __forceinline__ void gemm_phase(LAS unsigned char* lds, const Gemm g, const StaticOrder& S, const Epi& E, int wave_s) {
    const int tid = opaque_tid_w(wave_s), wid = __builtin_amdgcn_readfirstlane(tid >> 6), lane = tid & 63, wr = wid >> 2, wc = wid & 3, fr = lane & 15, fq = lane >> 4;
    const int K = g.K, nt = K / BK;
    unsigned voffA[2], voffB[2];
#pragma unroll
    for (int i = 0; i < 2; ++i) { int R, C; stage_rc(tid * 16 + i * 8192, R, C); const int Rb = (R & ~31) + perm32(R & 31);
        voffA[i] = (unsigned)(R * g.lda + C) * 2u; voffB[i] = (unsigned)(Rb * g.ldb + C) * 2u; }
    const size_t kstep = (size_t)(BK * 2);
    const size_t hstepA = (size_t)HALF * g.lda * 2, hstepB = (size_t)HALF * g.ldb * 2;
    const size_t tstepA = 2 * hstepA, tstepB = 2 * hstepB;
    const unsigned ldsw = (unsigned)wid * 1024u;
    const int aoff = lds_byte(wr * 64 + fr, fq * 8), boff = lds_byte(wc * 32 + fr, fq * 8);
#define PG8_SA(b, h) (((b) * 2 + (h)) * HTB)
#define PG8_SB(b, h) ((4 + (b) * 2 + (h)) * HTB)
#define PG8_STAGE(bufoff, gbase, voff) do { _Pragma("unroll") for (int _i = 0; _i < 2; ++_i) \
        __builtin_amdgcn_global_load_lds((const unsigned*)((const char*)(gbase) + (voff)[_i]), (LAS unsigned*)(lds + (bufoff) + ldsw + _i * 8192), 16, 0, 0); } while (0)
#define PG8_LDA(dst, b, h) do { _Pragma("unroll") for (int m = 0; m < 4; ++m) _Pragma("unroll") for (int k = 0; k < 2; ++k) dst[m][k] = *(const LAS bf16x8*)(lds + PG8_SA(b, h) + aoff + m * 2048 + k * 1024); } while (0)
#define PG8_LDB(dst, b, h) do { _Pragma("unroll") for (int n = 0; n < 2; ++n) _Pragma("unroll") for (int k = 0; k < 2; ++k) dst[n][k] = *(const LAS bf16x8*)(lds + PG8_SB(b, h) + boff + n * 2048 + k * 1024); } while (0)
#define PG8_MMA(ai, bj, At, Bt) do { __builtin_amdgcn_s_setprio(1); _Pragma("unroll") for (int m = 0; m < 4; ++m) _Pragma("unroll") for (int n = 0; n < 2; ++n) _Pragma("unroll") for (int k = 0; k < 2; ++k) \
        acc[ai][bj][m][n] = __builtin_amdgcn_mfma_f32_16x16x32_bf16(Bt[n][k], At[m][k], acc[ai][bj][m][n], 0, 0, 0); __builtin_amdgcn_s_setprio(0); } while (0)
#define PG8_WAIT_V(n) asm volatile("s_waitcnt vmcnt(" #n ")" ::: "memory")
#define PG8_WAIT_L(n) asm volatile("s_waitcnt lgkmcnt(" #n ")" ::: "memory")
#define PG8_BAR __builtin_amdgcn_s_barrier()
#define PG8_SCHED __builtin_amdgcn_sched_barrier(0)
    Unit cur, nxt; int ui = 0;
    if (!S.next(0, cur)) return;
    f32x4 acc[2][2][4][2];
#pragma unroll
    for (int a = 0; a < 2; ++a)
#pragma unroll
        for (int b = 0; b < 2; ++b)
#pragma unroll
            for (int m = 0; m < 4; ++m)
#pragma unroll
                for (int n = 0; n < 2; ++n) { float z; asm volatile("v_mov_b32 %0, 0" : "=v"(z)); acc[a][b][m][n] = (f32x4){z, z, z, z}; }
    bf16x8 At[4][2], B0[2][2], B1[2][2];
    const char* cA = (const char*)g.A + (size_t)cur.pm * tstepA; const char* cB = (const char*)g.Bt + (size_t)cur.pn * tstepB;
    PG8_STAGE(PG8_SB(0, 0), cB, voffB); PG8_STAGE(PG8_SB(0, 1), cB + hstepB, voffB); PG8_STAGE(PG8_SA(0, 0), cA, voffA); PG8_STAGE(PG8_SA(0, 1), cA + hstepA, voffA);
    if (wr == 1) PG8_BAR;
    PG8_WAIT_V(2); PG8_BAR;
    PG8_STAGE(PG8_SB(1, 0), cB + kstep, voffB); PG8_STAGE(PG8_SA(1, 0), cA + kstep, voffA); PG8_STAGE(PG8_SB(1, 1), cB + hstepB + kstep, voffB);
    PG8_WAIT_V(6); PG8_BAR;
    for (;;) {
        const bool has_next = S.next(ui + 1, nxt);
        const char* nA = has_next ? (const char*)g.A + (size_t)nxt.pm * tstepA : cA; const char* nB = has_next ? (const char*)g.Bt + (size_t)nxt.pn * tstepB : cB;
#pragma unroll 1
        for (int t = 0; t < nt; t += 2) {
            const bool last = (t == nt - 2);
            const char* a1 = cA + (size_t)(t + 1) * kstep;
            const char* a2 = last ? nA : cA + (size_t)(t + 2) * kstep; const char* b2 = last ? nB : cB + (size_t)(t + 2) * kstep;
            const char* a3 = a2 + kstep; const char* b3 = b2 + kstep;
            PG8_LDB(B0, 0, 0); PG8_LDB(B1, 0, 1); PG8_SCHED; PG8_LDA(At, 0, 0); PG8_STAGE(PG8_SA(1, 1), a1 + hstepA, voffA);
            PG8_WAIT_V(8); PG8_WAIT_L(0); PG8_BAR; PG8_MMA(0, 0, At, B0); PG8_MMA(0, 1, At, B1); PG8_BAR; PG8_SCHED;
            PG8_LDA(At, 0, 1); PG8_STAGE(PG8_SB(0, 0), b2, voffB); PG8_STAGE(PG8_SB(0, 1), b2 + hstepB, voffB); PG8_STAGE(PG8_SA(0, 0), a2, voffA);
            PG8_WAIT_V(8); PG8_WAIT_L(0); PG8_BAR; PG8_MMA(1, 0, At, B0); PG8_MMA(1, 1, At, B1); PG8_BAR; PG8_SCHED;
            PG8_LDB(B0, 1, 0); PG8_LDB(B1, 1, 1); PG8_SCHED; PG8_LDA(At, 1, 0); PG8_STAGE(PG8_SA(0, 1), a2 + hstepA, voffA);
            PG8_WAIT_V(8); PG8_WAIT_L(0); PG8_BAR; PG8_MMA(0, 0, At, B0); PG8_MMA(0, 1, At, B1); PG8_BAR; PG8_SCHED;
            PG8_LDA(At, 1, 1); PG8_STAGE(PG8_SB(1, 0), b3, voffB); PG8_STAGE(PG8_SB(1, 1), b3 + hstepB, voffB); PG8_STAGE(PG8_SA(1, 0), a3, voffA);
            PG8_WAIT_V(8); PG8_WAIT_L(0); PG8_BAR; PG8_MMA(1, 0, At, B0); PG8_MMA(1, 1, At, B1); PG8_BAR; PG8_SCHED;
        }
        E(acc, cur, wr, wc, fr, fq);
        if (!has_next) break;
#pragma unroll
        for (int a = 0; a < 2; ++a)
#pragma unroll
            for (int b = 0; b < 2; ++b)
#pragma unroll
                for (int m = 0; m < 4; ++m)
#pragma unroll
                    for (int n = 0; n < 2; ++n) { float z; asm volatile("v_mov_b32 %0, 0" : "=v"(z)); acc[a][b][m][n] = (f32x4){z, z, z, z}; }
        cur = nxt; cA = nA; cB = nB; ++ui;
    }
    PG8_WAIT_V(0);
    if (wr == 0) PG8_BAR;
    PG8_BAR;
#undef PG8_SA
#undef PG8_SB
#undef PG8_STAGE
#undef PG8_LDA
#undef PG8_LDB
#undef PG8_MMA
#undef PG8_WAIT_V
#undef PG8_WAIT_L
#undef PG8_BAR
#undef PG8_SCHED
}
}
using pg8::Unit;
typedef const f32x4 (&AccRef)[2][2][4][2];

__device__ __forceinline__ void rope8(f32x4& v0, f32x4& v1, const float* cs, const float* sn, int pos, int g) {
    const f32x4 c = *(const f32x4*)(cs + pos * 32 + 4 * g), s = *(const f32x4*)(sn + pos * 32 + 4 * g);
    const f32x4 a = v0 * c - v1 * s, b = v1 * c + v0 * s; v0 = a; v1 = b;
}
struct EpiU {
    bf16_t* U; const float* cs; const float* sn; const float* rh;
    __device__ __forceinline__ void operator()(AccRef acc, const Unit& u, int wr, int wc, int fr, int fq) const {
        const int row0 = u.pm * 256 + wr * 64 + fr;
        float rsv[2][4];
#pragma unroll
        for (int ai = 0; ai < 2; ++ai)
#pragma unroll
            for (int m = 0; m < 4; ++m) rsv[ai][m] = rh[row0 + ai * 128 + m * 16];
#pragma unroll
        for (int bj = 0; bj < 2; ++bj) {
            const int blk = u.pn * 256 + bj * 128 + wc * 32, col0 = blk + 8 * fq;
            const bool dosilu = blk >= U_FG && !(blk >= U_PP && blk < U_PG);
            const bool dorope = blk >= U_KR && blk < U_KR + 64;
#pragma unroll
            for (int ai = 0; ai < 2; ++ai)
#pragma unroll
                for (int m = 0; m < 4; ++m) {
                    const int row = row0 + ai * 128 + m * 16;
                    f32x4 v0 = acc[ai][bj][m][0] * rsv[ai][m], v1 = acc[ai][bj][m][1] * rsv[ai][m];
                    if (dorope) rope8(v0, v1, cs, sn, row % L, (col0 - U_KR) >> 3);
                    if (dosilu) {
#pragma unroll
                        for (int e = 0; e < 4; ++e) { v0[e] = silu_f(v0[e]); v1[e] = silu_f(v1[e]); }
                    }
                    *(u32x4*)(U + (size_t)row * UW + col0) = pack8(v0, v1);
                    __builtin_amdgcn_sched_barrier(0);
                }
        }
    }
};
struct EpiXT {
    bf16_t* XT; const float* rh;
    __device__ __forceinline__ void operator()(AccRef acc, const Unit& u, int wr, int wc, int fr, int fq) const {
        const int row0 = u.pm * 256 + wr * 64 + fr;
#pragma unroll
        for (int bj = 0; bj < 2; ++bj) {
            const int t0 = u.pn * 256 + bj * 128 + wc * 32 + 8 * fq, b = t0 / L, l = t0 - b * L;
            const f32x4 ra = *(const f32x4*)(rh + t0), rb = *(const f32x4*)(rh + t0 + 4);
#pragma unroll
            for (int ai = 0; ai < 2; ++ai)
#pragma unroll
                for (int m = 0; m < 4; ++m) {
                    const int np = row0 + ai * 128 + m * 16;
                    *(u32x4*)(XT + (size_t)(b * 256 + (np & 255)) * KD + (np >> 8) * LP + l) = pack8(acc[ai][bj][m][0] * ra, acc[ai][bj][m][1] * rb);
                }
        }
    }
};
struct EpiDFT {
    bf16_t* MIX; const bf16_t* U;
    __device__ __forceinline__ void operator()(AccRef acc, const Unit& u, int wr, int wc, int fr, int fq) const {
        const int row0 = u.pm * 256 + wr * 64 + fr, b = u.pn;
#pragma unroll
        for (int ai = 0; ai < 2; ++ai) {
            u32x4 gt[4][2];
#pragma unroll
            for (int m = 0; m < 4; ++m)
#pragma unroll
                for (int bj = 0; bj < 2; ++bj) gt[m][bj] = *(const u32x4*)(U + ((size_t)b * L + row0 + ai * 128 + m * 16) * UW + U_FG + bj * 128 + wc * 32 + 8 * fq);
#pragma unroll
            for (int m = 0; m < 4; ++m)
#pragma unroll
                for (int bj = 0; bj < 2; ++bj) { const size_t tok = (size_t)b * L + row0 + ai * 128 + m * 16; const int n = bj * 128 + wc * 32 + 8 * fq; const u32x4 g = gt[m][bj];
                    f32x4 v0 = acc[ai][bj][m][0], v1 = acc[ai][bj][m][1];
                    v0[0] *= bf_lo(g.x); v0[1] *= bf_hi(g.x); v0[2] *= bf_lo(g.y); v0[3] *= bf_hi(g.y);
                    v1[0] *= bf_lo(g.z); v1[1] *= bf_hi(g.z); v1[2] *= bf_lo(g.w); v1[3] *= bf_hi(g.w);
                    *(u32x4*)(MIX + tok * DM + n) = pack8(v0, v1); }
            __builtin_amdgcn_sched_barrier(0);
        }
    }
};
struct EpiQ {
    bf16_t* Q; const float* rq; const float* cs; const float* sn;
    __device__ __forceinline__ void operator()(AccRef acc, const Unit& u, int wr, int wc, int fr, int fq) const {
        const int row0 = u.pm * 256 + wr * 64 + fr;
        float rsv[2][4];
#pragma unroll
        for (int ai = 0; ai < 2; ++ai)
#pragma unroll
            for (int m = 0; m < 4; ++m) rsv[ai][m] = rq[row0 + ai * 128 + m * 16];
#pragma unroll
        for (int bj = 0; bj < 2; ++bj) {
            const int blk = u.pn * 256 + bj * 128 + wc * 32, col0 = blk + 8 * fq, w = blk % 192;
            const bool dorope = w >= 128;
#pragma unroll
            for (int ai = 0; ai < 2; ++ai)
#pragma unroll
                for (int m = 0; m < 4; ++m) {
                    const int row = row0 + ai * 128 + m * 16; const float rs = rsv[ai][m];
                    f32x4 v0 = acc[ai][bj][m][0] * rs, v1 = acc[ai][bj][m][1] * rs;
                    if (dorope) rope8(v0, v1, cs, sn, row % L, (w - 128 + 8 * fq) >> 3);
                    *(u32x4*)(Q + (size_t)row * QW + col0) = pack8(v0, v1);
                    if (m == 3) __builtin_amdgcn_sched_barrier(0);
                }
        }
    }
};
struct EpiKV {
    bf16_t* KV; const float* rkv;
    __device__ __forceinline__ void operator()(AccRef acc, const Unit& u, int wr, int wc, int fr, int fq) const {
        const int row0 = u.pm * 256 + wr * 64 + fr;
        float rsv[2][4];
#pragma unroll
        for (int ai = 0; ai < 2; ++ai)
#pragma unroll
            for (int m = 0; m < 4; ++m) rsv[ai][m] = rkv[row0 + ai * 128 + m * 16];
#pragma unroll
        for (int ai = 0; ai < 2; ++ai)
#pragma unroll
            for (int m = 0; m < 4; ++m) {
                const int row = row0 + ai * 128 + m * 16; const float rs = rsv[ai][m];
#pragma unroll
                for (int bj = 0; bj < 2; ++bj) {
                    const int col0 = u.pn * 256 + bj * 128 + wc * 32 + 8 * fq;
                    *(u32x4*)(KV + (size_t)row * KVW + col0) = pack8(acc[ai][bj][m][0] * rs, acc[ai][bj][m][1] * rs);
                }
            }
    }
};
struct EpiOut {
    bf16_t* H;
    __device__ __forceinline__ void operator()(AccRef acc, const Unit& u, int wr, int wc, int fr, int fq) const {
        const int row0 = u.pm * 256 + wr * 64 + fr;
#pragma unroll
        for (int ai = 0; ai < 2; ++ai) {
            u32x4 hv[4][2];
#pragma unroll
            for (int m = 0; m < 4; ++m)
#pragma unroll
                for (int bj = 0; bj < 2; ++bj) hv[m][bj] = *(const u32x4*)(H + (size_t)(row0 + ai * 128 + m * 16) * DM + u.pn * 256 + bj * 128 + wc * 32 + 8 * fq);
#pragma unroll
            for (int m = 0; m < 4; ++m)
#pragma unroll
                for (int bj = 0; bj < 2; ++bj) { const u32x4 g = hv[m][bj]; f32x4 v0 = acc[ai][bj][m][0], v1 = acc[ai][bj][m][1];
                    v0[0] += bf_lo(g.x); v0[1] += bf_hi(g.x); v0[2] += bf_lo(g.y); v0[3] += bf_hi(g.y);
                    v1[0] += bf_lo(g.z); v1[1] += bf_hi(g.z); v1[2] += bf_lo(g.w); v1[3] += bf_hi(g.w);
                    *(u32x4*)(H + (size_t)(row0 + ai * 128 + m * 16) * DM + u.pn * 256 + bj * 128 + wc * 32 + 8 * fq) = pack8(v0, v1); }
            __builtin_amdgcn_sched_barrier(0);
        }
    }
};
struct EpiAll {
    int kind; unsigned char* ws;
    __device__ __forceinline__ void operator()(AccRef acc, const Unit& u, int wr, int wc, int fr, int fq) const {
        asm volatile("" : "+v"(fr), "+v"(fq));
        bf16_t* U = (bf16_t*)(ws + WS_U); const float* COS = (const float*)(ws + WS_COS); const float* SIN = (const float*)(ws + WS_SIN);
        switch (kind) {
            case 0: { EpiU E{U, COS, SIN, (const float*)(ws + WS_RH)}; E(acc, u, wr, wc, fr, fq); break; }
            case 1: { EpiXT E{(bf16_t*)(ws + WS_XT), (const float*)(ws + WS_RH)}; E(acc, u, wr, wc, fr, fq); break; }
            case 2: { EpiDFT E{(bf16_t*)(ws + WS_HN), U}; E(acc, u, wr, wc, fr, fq); break; }
            case 3: { EpiQ E{(bf16_t*)(ws + WS_Q), (const float*)(ws + WS_RQ), COS, SIN}; E(acc, u, wr, wc, fr, fq); break; }
            case 4: { EpiKV E{(bf16_t*)(ws + WS_KV), (const float*)(ws + WS_RKV)}; E(acc, u, wr, wc, fr, fq); break; }
            default: { EpiOut E{(bf16_t*)(ws + WS_H)}; E(acc, u, wr, wc, fr, fq); break; }
        }
    }
};

namespace att {
constexpr int NW = 8, QBLK = 32, KVBLK = 64, NT = 65;
constexpr float SCALE = 0.07216878364870322f, THR = 8.f;
constexpr int SHM_V = 16384, SHM_K = 16384, SHM_R = 8192;
constexpr int OFF_V = 0, OFF_K = 2 * SHM_V, OFF_R = OFF_K + 2 * SHM_K, OFF_WS = OFF_R + 2 * SHM_R, OFF_QR = OFF_WS + 2048;
#define KSWZ(row, colB) ((row) * 256 + ((colB) ^ (((row) & 7) << 4)))
#define RSWZ(row, colB) ((row) * 128 + ((colB) ^ (((row) & 7) << 4)))
#define SBAR() __builtin_amdgcn_sched_barrier(0)
__device__ __forceinline__ int crow(int r, int hi) { return (r & 3) + 8 * (r >> 2) + 4 * hi; }
__device__ __forceinline__ void partialSM(f32x16& p0, f32x16& p1, float& m_reg, float& mn, float& alpha) {
    constexpr float C = SCALE * 1.4426950408889634f;
    float pmax = p0[0];
#pragma unroll
    for (int r = 1; r < 16; ++r) pmax = fmaxf(pmax, p0[r]);
#pragma unroll
    for (int r = 0; r < 16; ++r) pmax = fmaxf(pmax, p1[r]);
    { auto rr = __builtin_amdgcn_permlane32_swap(__float_as_uint(pmax), __float_as_uint(pmax), false, false);
      pmax = fmaxf(__uint_as_float(rr[0]), __uint_as_float(rr[1])); }
    if (__builtin_expect(__all(pmax - m_reg <= THR / SCALE), 1)) { mn = m_reg; alpha = 1.f; }
    else { mn = fmaxf(m_reg, pmax); alpha = __builtin_amdgcn_exp2f((m_reg - mn) * C); m_reg = mn; }
    const float mnC = -mn * C;
#pragma unroll
    for (int r = 0; r < 16; ++r) p0[r] = fmaf(p0[r], C, mnC);
#pragma unroll
    for (int r = 0; r < 16; ++r) p1[r] = fmaf(p1[r], C, mnC);
#pragma unroll
    for (int r = 0; r < 16; ++r) p0[r] = __builtin_amdgcn_exp2f(p0[r]);
}
__device__ __forceinline__ void finishSM(f32x16& p0, f32x16& p1, float alpha, float& l_reg, bf16x8& pa0, bf16x8& pa1, bf16x8& pa2, bf16x8& pa3) {
#pragma unroll
    for (int r = 0; r < 16; ++r) p1[r] = __builtin_amdgcn_exp2f(p1[r]);
    float ps = 0;
#pragma unroll
    for (int r = 0; r < 16; ++r) ps += p0[r];
#pragma unroll
    for (int r = 0; r < 16; ++r) ps += p1[r];
    { auto rr = __builtin_amdgcn_permlane32_swap(__float_as_uint(ps), __float_as_uint(ps), false, false);
      ps = __uint_as_float(rr[0]) + __uint_as_float(rr[1]); }
    l_reg = l_reg * alpha + ps;
#define PK4(P, BASE, OUT) do { unsigned a0 = cvt_pk_bf16(P[BASE + 0], P[BASE + 1]), a1 = cvt_pk_bf16(P[BASE + 2], P[BASE + 3]);   \
    unsigned b0 = cvt_pk_bf16(P[BASE + 4], P[BASE + 5]), b1 = cvt_pk_bf16(P[BASE + 6], P[BASE + 7]);                              \
    auto r0 = __builtin_amdgcn_permlane32_swap(a0, b0, false, false); auto r1 = __builtin_amdgcn_permlane32_swap(a1, b1, false, false); \
    u32x4 w = {r0[0], r1[0], r0[1], r1[1]}; OUT = *reinterpret_cast<bf16x8*>(&w); } while (0)
    PK4(p0, 0, pa0); PK4(p0, 8, pa1); PK4(p1, 0, pa2); PK4(p1, 8, pa3);
#undef PK4
}
__device__ __forceinline__ void qkt(f32x16& p0, f32x16& p1, const char* Ks, const char* Rs, const bf16x8* qr, const char* qrl, int r32, int hi) {
    p0 = f32x16{}; p1 = f32x16{};
#pragma unroll
    for (int d0 = 0; d0 < 8; ++d0) { const int cb = (d0 * 16 + hi * 8) * 2;
        bf16x8 b0 = *reinterpret_cast<const bf16x8*>(Ks + KSWZ(r32, cb));
        bf16x8 b1 = *reinterpret_cast<const bf16x8*>(Ks + KSWZ(32 + r32, cb));
        p0 = __builtin_amdgcn_mfma_f32_32x32x16_bf16(b0, qr[d0], p0, 0, 0, 0);
        p1 = __builtin_amdgcn_mfma_f32_32x32x16_bf16(b1, qr[d0], p1, 0, 0, 0); }
#pragma unroll
    for (int d0 = 0; d0 < 4; ++d0) { const int cb = (d0 * 16 + hi * 8) * 2;
        bf16x8 b0 = *reinterpret_cast<const bf16x8*>(Rs + RSWZ(r32, cb));
        bf16x8 b1 = *reinterpret_cast<const bf16x8*>(Rs + RSWZ(32 + r32, cb));
        const bf16x8 qv = *reinterpret_cast<const bf16x8*>(qrl + d0 * 1024);
        p0 = __builtin_amdgcn_mfma_f32_32x32x16_bf16(b0, qv, p0, 0, 0, 0);
        p1 = __builtin_amdgcn_mfma_f32_32x32x16_bf16(b1, qv, p1, 0, 0, 0); }
}
__device__ __forceinline__ void kmask(f32x16& p0, f32x16& p1, int k0, int hi) {
#pragma unroll
    for (int r = 0; r < 16; ++r) { const int kv = k0 + crow(r, hi); if (kv >= L) p0[r] = -1e30f; if (kv + 32 >= L) p1[r] = -1e30f; }
}
__device__ __forceinline__ int v_st(int k, int c) { const int kk = (k & ~0xC) | ((k & 4) << 1) | ((k & 8) >> 1); return ((kk >> 3) * 4 + (c >> 5)) * 512 + ((kk & 7) * 32 + (c & 31)) * 2; }
__device__ __forceinline__ int v_rd_base(int lane) { return ((lane & 3) << 3) | (((lane >> 2) & 3) << 6) | (((lane >> 4) & 1) << 5) | (((lane >> 5) & 1) << 8); }
constexpr int v_rd_off(int d0, int ks, int half) { return d0 * 512 + ks * 4096 + half * 2048; }
template <int OFF> __device__ __forceinline__ s16x4 tr_read(int vb) {
    s16x4 r; asm volatile("ds_read_b64_tr_b16 %0, %1 offset:%2" : "=&v"(r) : "v"(vb), "i"(OFF) : "memory"); return r;
}
template <int D0> __device__ __forceinline__ void pv_one(f32x16& od, int vb, bf16x8 pa0, bf16x8 pa1, bf16x8 pa2, bf16x8 pa3) {
    const s16x4 l0 = tr_read<v_rd_off(D0, 0, 0)>(vb), h0 = tr_read<v_rd_off(D0, 0, 1)>(vb), l1 = tr_read<v_rd_off(D0, 1, 0)>(vb), h1 = tr_read<v_rd_off(D0, 1, 1)>(vb);
    const s16x4 l2 = tr_read<v_rd_off(D0, 2, 0)>(vb), h2 = tr_read<v_rd_off(D0, 2, 1)>(vb), l3 = tr_read<v_rd_off(D0, 3, 0)>(vb), h3 = tr_read<v_rd_off(D0, 3, 1)>(vb);
    asm volatile("s_waitcnt lgkmcnt(0)" ::: "memory"); SBAR();
#define PK(Lx, Hx) (bf16x8){Lx[0], Lx[1], Lx[2], Lx[3], Hx[0], Hx[1], Hx[2], Hx[3]}
    od = __builtin_amdgcn_mfma_f32_32x32x16_bf16(pa0, PK(l0, h0), od, 0, 0, 0);
    od = __builtin_amdgcn_mfma_f32_32x32x16_bf16(pa1, PK(l1, h1), od, 0, 0, 0);
    od = __builtin_amdgcn_mfma_f32_32x32x16_bf16(pa2, PK(l2, h2), od, 0, 0, 0);
    od = __builtin_amdgcn_mfma_f32_32x32x16_bf16(pa3, PK(l3, h3), od, 0, 0, 0);
#undef PK
}
__device__ __forceinline__ void pv_d0(f32x16* o, int vb, bf16x8 pa0, bf16x8 pa1, bf16x8 pa2, bf16x8 pa3) {
    pv_one<0>(o[0], vb, pa0, pa1, pa2, pa3); pv_one<1>(o[1], vb, pa0, pa1, pa2, pa3); pv_one<2>(o[2], vb, pa0, pa1, pa2, pa3); pv_one<3>(o[3], vb, pa0, pa1, pa2, pa3);
}

__device__ __forceinline__ int swap23(int k) { return (k & ~0xC) | ((k & 4) << 1) | ((k & 8) >> 1); }
__device__ __forceinline__ void attn_unit(int b, int h, int qb, const bf16_t* __restrict__ Q, const bf16_t* __restrict__ KV, const bf16_t* __restrict__ U,
                                          bf16_t* __restrict__ MIX, char* lds, LAS unsigned char* ldsl, int t_begin, int t_end, float* __restrict__ part, int wave_s) {
    const int tid = opaque_tid_w(wave_s), wid = tid >> 6, lane = tid & 63, r32 = lane & 31, hi = lane >> 5;
    const int widu = __builtin_amdgcn_readfirstlane(wid);
    char* V_lds = lds + OFF_V; char* K_lds = lds + OFF_K; char* R_lds = lds + OFF_R;
    float* ws = (float*)(lds + OFF_WS) + wid * 64; float* li_l = ws; float* al_l = ws + 32;
    float m_reg = -1e30f, l_reg = 0; f32x16 o[4] = {}; bf16x8 qr[8];
    char* qrl = lds + OFF_QR + wid * 4096 + lane * 16;
    const size_t tok0 = (size_t)b * L;
    __syncthreads();
    { int qrow = qb * 256 + wid * QBLK + r32; if (qrow > L - 1) qrow = L - 1;
      const bf16_t* Qw = Q + (tok0 + qrow) * QW + h * 192 + hi * 8;
#pragma unroll
      for (int d0 = 0; d0 < 8; ++d0) qr[d0] = *(const bf16x8*)(Qw + d0 * 16);
#pragma unroll
      for (int d0 = 0; d0 < 4; ++d0) *(bf16x8*)(qrl + d0 * 1024) = *(const bf16x8*)(Qw + (8 + d0) * 16); }
    const char* Kh = (const char*)(KV + tok0 * KVW + h * 256); const char* Vh = Kh + 256; const char* Rh = (const char*)(U + tok0 * UW + U_KR);
    int rowK[2], colK[2], keyV[2], colV[2];
#pragma unroll
    for (int i = 0; i < 2; ++i) { const int pc = 2 * wid + i; rowK[i] = 4 * pc + (lane >> 4); colK[i] = ((lane & 15) ^ (rowK[i] & 7)) * 16;
        const int off = pc * 1024 + lane * 16, st = off >> 9; keyV[i] = swap23((st >> 2) * 8 + ((off & 511) >> 6)); colV[i] = ((st & 3) * 32 + ((off >> 4) & 3) * 8) * 2; }
    const int rowR = 8 * wid + (lane >> 3), colR = ((lane & 7) ^ (rowR & 7)) * 16;
    const int vb0 = (int)(uintptr_t)V_lds + v_rd_base(lane);
#define CLK(k) ((k) < L ? (k) : L - 1)
#define DMA_KR(bb, k0) do { _Pragma("unroll") for (int _i = 0; _i < 2; ++_i) \
        __builtin_amdgcn_global_load_lds((const unsigned*)(Kh + (unsigned)(CLK((k0) + rowK[_i]) * (KVW * 2) + colK[_i])), (LAS unsigned*)(ldsl + OFF_K + (bb) * SHM_K + (2 * widu + _i) * 1024), 16, 0, 0); \
        __builtin_amdgcn_global_load_lds((const unsigned*)(Rh + (unsigned)(CLK((k0) + rowR) * (UW * 2) + colR)), (LAS unsigned*)(ldsl + OFF_R + (bb) * SHM_R + widu * 1024), 16, 0, 0); } while (0)
#define DMA_V(bb, k0) do { _Pragma("unroll") for (int _i = 0; _i < 2; ++_i) \
        __builtin_amdgcn_global_load_lds((const unsigned*)(Vh + (unsigned)(CLK((k0) + keyV[_i]) * (KVW * 2) + colV[_i])), (LAS unsigned*)(ldsl + OFF_V + (bb) * SHM_V + (2 * widu + _i) * 1024), 16, 0, 0); } while (0)
#define WAITBAR() do { asm volatile("s_waitcnt vmcnt(0) lgkmcnt(0)" ::: "memory"); __builtin_amdgcn_s_barrier(); asm volatile("" ::: "memory"); } while (0)
    const int N = t_end - t_begin;
    DMA_KR(0, t_begin * KVBLK); DMA_V(0, t_begin * KVBLK); DMA_KR(1, (t_begin + 1) * KVBLK);
    WAITBAR();
    f32x16 pn0, pn1;
    qkt(pn0, pn1, K_lds, R_lds, qr, qrl, r32, hi);
    WAITBAR();
#define ATT_BODY(MASKED) do { const int bb = j & 1, jt = t_begin + j; \
        if (j + 1 < N) DMA_V(bb ^ 1, (jt + 1) * KVBLK); \
        if (j + 2 < N) DMA_KR(bb, (jt + 2) * KVBLK); \
        f32x16 p0 = pn0, p1 = pn1; float mn, al; bf16x8 pa0, pa1, pa2, pa3; \
        if (MASKED) kmask(p0, p1, jt * KVBLK, hi); \
        qkt(pn0, pn1, K_lds + (bb ^ 1) * SHM_K, R_lds + (bb ^ 1) * SHM_R, qr, qrl, r32, hi);     \
        partialSM(p0, p1, m_reg, mn, al); \
        if (__any(al < 1.f)) { if (hi == 0) al_l[r32] = al; asm volatile("s_waitcnt lgkmcnt(0)" ::: "memory"); \
            _Pragma("unroll") for (int d = 0; d < 4; ++d) _Pragma("unroll") for (int r = 0; r < 16; ++r) o[d][r] *= al_l[crow(r, hi)]; } \
        finishSM(p0, p1, al, l_reg, pa0, pa1, pa2, pa3); SBAR(); \
        pv_d0(o, vb0 + bb * SHM_V, pa0, pa1, pa2, pa3); \
        WAITBAR(); } while (0)
    int j = 0;
#pragma unroll 1
    for (; j < N && (t_begin + j + 1) * KVBLK <= L; ++j) ATT_BODY(false);
#pragma unroll 1
    for (; j < N; ++j) ATT_BODY(true);
#undef ATT_BODY
    if (part) {
        if (wid == 0) {
#pragma unroll
            for (int r = 0; r < 16; ++r) { const int orow = crow(r, hi);
                if (orow < 16) {
#pragma unroll
                    for (int d0 = 0; d0 < 4; ++d0) part[orow * 128 + d0 * 32 + r32] = o[d0][r]; } }
            if (lane < 16) { part[2048 + lane] = m_reg; part[2064 + lane] = l_reg; }
        }
        return;
    }
    if (hi == 0) li_l[r32] = l_reg; asm volatile("s_waitcnt lgkmcnt(0)" ::: "memory");
    const int rbase = qb * 256 + wid * QBLK;
#pragma unroll
    for (int rh = 0; rh < 2; ++rh) {
        unsigned short gt[8][4];
#pragma unroll
        for (int r8 = 0; r8 < 8; ++r8) { const int r = rh * 8 + r8, prow = min(rbase + crow(r, hi), L - 1); const size_t t = tok0 + prow;
#pragma unroll
            for (int d0 = 0; d0 < 4; ++d0) gt[r8][d0] = U[t * UW + U_AG + h * 128 + d0 * 32 + r32]; }
#pragma unroll
        for (int r8 = 0; r8 < 8; ++r8) { const int r = rh * 8 + r8, orow = crow(r, hi), prow = rbase + orow;
            const float rli = __builtin_amdgcn_rcpf(li_l[orow]);
            if (prow < L) { const size_t t = tok0 + prow;
#pragma unroll
                for (int d0 = 0; d0 < 4; ++d0) { const int c = h * 128 + d0 * 32 + r32;
                    const float ov = o[d0][r] * rli * bf1(gt[r8][d0]); MIX[t * DM + 512 + c] = (bf16_t)(cvt_pk_bf16(ov, ov) & 0xffffu); } } }
    }
#undef DMA_KR
#undef DMA_V
#undef WAITBAR
#undef CLK
}
}

struct Args {
    const float* x; const float* meta; const float* norm_w; const float* w_in; const float* fourier_w; const float* pool_w; const float* pool_scale;
    const float* q_norm_w; const float* w_uq; const float* kv_norm_w; const float* w_ukv; const float* w_out; const float* final_norm_w;
    float* out; unsigned char* ws; int ph_lo, ph_hi;
};

__device__ __forceinline__ float wsrc(const Args& a, int layer, int mat, int k, int j) {
    const float* w_in = a.w_in + (size_t)layer * DM * DIN + (size_t)k * DIN;
    if (mat == 0) {
        const float nw = a.norm_w[layer * DM + k];
        if (j < 384) return w_in[1024 + j] * nw;
        if (j < 448) return w_in[1664 + rope_src(j - 384)] * nw;
        if (j < 512) return 0.f;
        if (j < 768) return w_in[1408 + j - 512] * nw;
        if (j < 1024) return w_in[256 + j - 768] * nw;
        if (j < 1280) return 0.f;
        if (j < 1536) return w_in[768 + j - 1280] * nw;
        return w_in[1728 + j - 1536] * nw;
    } else if (mat == 1) {
        return 0.f;
    } else if (mat == 2) {
        const int hh = j / 192, w = j % 192; const int col = w < 128 ? j : hh * 192 + 128 + rope_src(w - 128);
        return a.w_uq[((size_t)layer * 384 + k) * 768 + col] * a.q_norm_w[layer * 384 + k];
    } else if (mat == 3) {
        return a.w_ukv[((size_t)layer * 256 + k) * 1024 + j] * a.kv_norm_w[layer * 256 + k];
    }
    return a.w_out[((size_t)layer * 1024 + k) * 1024 + j];
}
__device__ __forceinline__ void prep_item(const Args& a, int layer, int mat, int K, bf16_t* WT, int item, int nblk, LAS float* scr, int lane) {
    const int kb = item / nblk, nb = item % nblk, k0 = 64 * kb, n0 = 32 * nb;
#pragma unroll 1
    for (int i0 = 0; i0 < 32; i0 += 8) { float tv[8];
#pragma unroll
        for (int e = 0; e < 8; ++e) tv[e] = wsrc(a, layer, mat, k0 + 2 * (i0 + e) + (lane >> 5), n0 + (lane & 31));
#pragma unroll
        for (int e = 0; e < 8; ++e) scr[(2 * (i0 + e) + (lane >> 5)) * 33 + (lane & 31)] = tv[e]; }
    asm volatile("s_waitcnt lgkmcnt(0)" ::: "memory");
    const int c = lane & 7;
#pragma unroll
    for (int jx = 0; jx < 4; ++jx) { const int n = (lane >> 3) + 8 * jx; const LAS float* s = scr + (8 * c) * 33 + n;
        u32x4 o; o.x = cvt_pk_bf16(s[0 * 33], s[1 * 33]); o.y = cvt_pk_bf16(s[2 * 33], s[3 * 33]); o.z = cvt_pk_bf16(s[4 * 33], s[5 * 33]); o.w = cvt_pk_bf16(s[6 * 33], s[7 * 33]);
        *(u32x4*)(WT + (size_t)(n0 + n) * K + k0 + 8 * c) = o; }
    asm volatile("s_waitcnt lgkmcnt(0)" ::: "memory");
}


__device__ __forceinline__ void fold_item(const float* __restrict__ w_in_l, const float* __restrict__ nw, const float* __restrict__ F, float fscale, int base, bf16_t* WT, int row0, int k0, int lane) {
    float Freg[64];
#pragma unroll
    for (int c = 0; c < 64; ++c) Freg[c] = F[c * 64 + lane] * fscale;
#pragma unroll 1
    for (int kk0 = 0; kk0 < 64; kk0 += 8) {
        float av[8], acc[8];
#pragma unroll
        for (int e = 0; e < 8; ++e) { av[e] = w_in_l[(size_t)(k0 + kk0 + e) * DIN + base + lane]; acc[e] = 0.f; }
#pragma unroll
        for (int c = 0; c < 64; ++c) { const float f = Freg[c];
#pragma unroll
            for (int e = 0; e < 8; ++e) acc[e] += __uint_as_float((unsigned)__builtin_amdgcn_readlane((int)__float_as_uint(av[e]), c)) * f; }
#pragma unroll
        for (int e = 0; e < 8; ++e) acc[e] *= nw[k0 + kk0 + e];
        u32x4 o; o.x = cvt_pk_bf16(acc[0], acc[1]); o.y = cvt_pk_bf16(acc[2], acc[3]); o.z = cvt_pk_bf16(acc[4], acc[5]); o.w = cvt_pk_bf16(acc[6], acc[7]);
        *(u32x4*)(WT + (size_t)(row0 + lane) * 1024 + k0 + kk0) = o;
    }
}


#define XB_TMO      128
#define XB_XCNT(j)  (256  + 64 * (j))
#define XB_XSUB(j)  (1280 + 64 * (j))
#define XB_XGEN(j)  (2304 + 64 * (j))
#define XB_TOP      3328
#define XB_TOPGEN   3392
#define XCD_BAR_WORDS 3456
#define XB_SPIN_CAP (1u << 18)
__device__ __forceinline__ unsigned xb_ld(unsigned* p)              { return __hip_atomic_load(p, __ATOMIC_RELAXED, __HIP_MEMORY_SCOPE_AGENT); }
__device__ __forceinline__ unsigned xb_add(unsigned* p, unsigned v) { return __hip_atomic_fetch_add(p, v, __ATOMIC_RELAXED, __HIP_MEMORY_SCOPE_AGENT); }
__device__ __forceinline__ unsigned xb_xcc_id() { return (unsigned)__builtin_amdgcn_s_getreg((3 << 11) | 20) & 0xFu; }
#define XB_SPIN(cond, bar) do { unsigned _sp = 0; while (cond) { __builtin_amdgcn_s_sleep(1); \
    if ((++_sp & 255u) == 0u) { if (xb_ld(&(bar)[XB_TMO])) break; if (_sp > XB_SPIN_CAP) { atomicAdd(&(bar)[XB_TMO], 1u); break; } } } } while (0)
__device__ __forceinline__ void xcd_barrier_complete(unsigned* bar, unsigned x, unsigned& nloc, unsigned& nx) {
    const unsigned G = gridDim.x;
    unsigned sum, cnt, mine, sp = 0u;
    for (;;) {
        sum = 0u; cnt = 0u; mine = 0u;
#pragma unroll
        for (unsigned j = 0; j < 16; ++j) { const unsigned c = xb_ld(&bar[XB_XCNT(j)]); sum += c; cnt += (c > 0u) ? 1u : 0u; mine = (j == x) ? c : mine; }
        if (sum == G) break;
        __builtin_amdgcn_s_sleep(1);
        if ((++sp & 255u) == 0u) { if (xb_ld(&bar[XB_TMO])) break; if (sp > XB_SPIN_CAP) { atomicAdd(&bar[XB_TMO], 1u); break; } }
    }
    nloc = mine > 0u ? mine : 1u; nx = cnt > 0u ? cnt : 1u;
}
__device__ __forceinline__ void xcd_barrier(unsigned* bar, volatile LAS unsigned* st, bool leader) {
    asm volatile("s_waitcnt vmcnt(0)" ::: "memory");
    __syncthreads();
    if (leader) {
        const unsigned x = xb_xcc_id();
        __builtin_amdgcn_s_waitcnt(0);
        unsigned nloc = st[0], nx = st[1];
        if (nloc == 0u) { xcd_barrier_complete(bar, x, nloc, nx); st[0] = nloc; st[1] = nx; }
        const unsigned old = xb_add(&bar[XB_XSUB(x)], 1u);
        const unsigned gen = old / nloc;
        if (old + 1u == (gen + 1u) * nloc) {
            __builtin_amdgcn_fence(__ATOMIC_RELEASE, "agent");
            asm volatile("s_waitcnt vmcnt(0)" ::: "memory");
            const unsigned og = xb_add(&bar[XB_TOP], 1u);
            const unsigned tg = og / nx;
            if (og + 1u == (tg + 1u) * nx) xb_add(&bar[XB_TOPGEN], 1u);
            else XB_SPIN(xb_ld(&bar[XB_TOPGEN]) == tg, bar);
            __builtin_amdgcn_fence(__ATOMIC_ACQUIRE, "agent");
            xb_add(&bar[XB_XGEN(x)], 1u);
            asm volatile("s_waitcnt vmcnt(0)" ::: "memory");
        } else {
            XB_SPIN(xb_ld(&bar[XB_XGEN(x)]) == gen, bar);
            __builtin_amdgcn_fence(__ATOMIC_ACQUIRE, "agent");
            asm volatile("s_waitcnt vmcnt(0)" ::: "memory");
        }
    }
    __syncthreads();
}

#ifndef PHMASK
#define PHMASK 0xFF
#endif
#define PHM(k) ((PHMASK >> (k)) & 1)
#ifndef Q3
#define Q3 15
#endif
__global__ void __launch_bounds__(512) hymba_fwd(Args a) {
    extern __shared__ __attribute__((aligned(16))) unsigned char lds[];
    cg::grid_group grid = cg::this_grid();
    const int wave_s = __builtin_amdgcn_readfirstlane((int)threadIdx.x >> 6);
    if (threadIdx.x == 0) { volatile LAS unsigned* xst0 = (volatile LAS unsigned*)((LAS unsigned char*)lds + 135168); xst0[0] = 0u; xst0[1] = 0u;
        (void)xb_add(&((unsigned*)(a.ws + WS_BAR))[XB_XCNT(xb_xcc_id())], 1u); }
    __syncthreads();
#pragma unroll 1
    for (int ph = a.ph_lo; ph < a.ph_hi; ++ph) {
    size_t wz = 0; asm volatile("" : "+s"(wz));
    unsigned char* ws = a.ws + wz;
    const int tid = opaque_tid_w(wave_s), lane = tid & 63, wave = __builtin_amdgcn_readfirstlane(tid >> 6);
    int G = gridDim.x, bx = blockIdx.x; asm volatile("" : "+s"(G), "+s"(bx));
    const int vcu = (G % 8 == 0) ? (bx % 8) * (G / 8) + bx / 8 : bx;
    const int gw = vcu * 8 + wave, NGW = G * 8;
    bf16_t* H = (bf16_t*)(ws + WS_H); float* RH = (float*)(ws + WS_RH); bf16_t* MIX = (bf16_t*)(ws + WS_HN); bf16_t* U = (bf16_t*)(ws + WS_U);
    bf16_t* XT = (bf16_t*)(ws + WS_XT); bf16_t* DFT = (bf16_t*)(ws + WS_DFT); bf16_t* Qb = (bf16_t*)(ws + WS_Q); bf16_t* KVb = (bf16_t*)(ws + WS_KV);
    bf16_t* WN = (bf16_t*)(ws + WS_WN); bf16_t* WF = (bf16_t*)(ws + WS_WF); bf16_t* WQ = (bf16_t*)(ws + WS_WQ); bf16_t* WKV = (bf16_t*)(ws + WS_WKV); bf16_t* WO = (bf16_t*)(ws + WS_WO);
    float* RQ = (float*)(ws + WS_RQ); float* RKV = (float*)(ws + WS_RKV); float* COS = (float*)(ws + WS_COS); float* SIN = (float*)(ws + WS_SIN);
    float* CWF = (float*)(ws + WS_CWF); float* SWF = (float*)(ws + WS_SWF);
    LAS unsigned char* ldsl = (LAS unsigned char*)lds;
    {
        if (ph == 0 && PHM(6)) {
            float* tabc = (float*)lds; float* tabs = tabc + L;
            for (int m = tid; m < L; m += 512) { float s, c; sincospif(2.0f * (float)m / (float)L, &s, &c); tabc[m] = c; tabs[m] = s; }
            __syncthreads();
            for (int k = bx; k < L; k += G) {
                bf16_t* row = DFT + (size_t)k * KF;
                for (int ch = tid; ch < KF / 8; ch += 512) {
                    const int c0 = ch * 8, hs = c0 >= LF, l0 = c0 - hs * LF;
                    int idx = (int)(((long)k * l0) % L); float v[8];
#pragma unroll
                    for (int e = 0; e < 8; ++e) { const bool ok = (l0 + e) <= LH; v[e] = ok ? (hs ? -tabs[idx] : tabc[idx]) : 0.f; idx += k; if (idx >= L) idx -= L; }
                    u32x4 o; o.x = cvt_pk_bf16(v[0], v[1]); o.y = cvt_pk_bf16(v[2], v[3]); o.z = cvt_pk_bf16(v[4], v[5]); o.w = cvt_pk_bf16(v[6], v[7]);
                    *(u32x4*)(row + c0) = o;
                }
            }
            for (int i = bx * 512 + tid; i < L * 32; i += G * 512) { const int pos = i >> 5, ii = i & 31;
                const float inv = 1.0f / powf(10000.0f, (float)(2 * ii) / 64.0f); const float ang = (float)pos * inv; float s, c; sincosf(ang, &s, &c); COS[i] = c; SIN[i] = s; }
            for (int i = bx * 512 + tid; i < DEPTH * 4 * 64 * 64; i += G * 512) { const int d = i & 63, c = (i >> 6) & 63, lh = i >> 12;
                const float* Wf = a.fourier_w + (size_t)lh * 4096 + d; float sc_ = 0.f, ss_ = 0.f;
                for (int e = 0; e < 64; ++e) { float s, cc; sincospif((float)((c * e) & 63) / 32.0f, &s, &cc); const float w = Wf[e * 64]; sc_ += cc * w; ss_ += s * w; }
                const float nrm = rsqrtf((float)L * 64.0f); CWF[i] = sc_ * nrm; SWF[i] = ss_ * nrm; }
            for (int i = bx * 512 + tid; i < 4096 * 2 * 14; i += G * 512) { const int ch = i % 14, hs = (i / 14) & 1, r = i / 28;
                const unsigned z = __float_as_uint(opaque_zero()); *(u32x4*)(XT + (size_t)r * KD + hs * LP + L + ch * 8) = (u32x4){z, z, z, z}; }
            __syncthreads();
        } else if (ph == 1 + 6 * DEPTH && PHM(7)) {
            for (int r = gw; r < NB * SEQ; r += NGW) { const int b = r >> 12, s = r & 4095;
                const u32x4* xr = (const u32x4*)(H + ((size_t)b * L + NMETA + s) * DM) + lane; const u32x4 x0 = xr[0], x1 = xr[64];
                float v[16]; v[0] = bf_lo(x0.x); v[1] = bf_hi(x0.x); v[2] = bf_lo(x0.y); v[3] = bf_hi(x0.y); v[4] = bf_lo(x0.z); v[5] = bf_hi(x0.z); v[6] = bf_lo(x0.w); v[7] = bf_hi(x0.w);
                v[8] = bf_lo(x1.x); v[9] = bf_hi(x1.x); v[10] = bf_lo(x1.y); v[11] = bf_hi(x1.y); v[12] = bf_lo(x1.z); v[13] = bf_hi(x1.z); v[14] = bf_lo(x1.w); v[15] = bf_hi(x1.w);
                float ss = 0.f;
#pragma unroll
                for (int e = 0; e < 16; ++e) ss += v[e] * v[e];
                const float rstd = rsqrtf(wave_sum(ss) * (1.f / DM) + NORM_EPS);
                float* orow = a.out + (size_t)r * DM; const float* fw = a.final_norm_w;
#pragma unroll
                for (int hlf = 0; hlf < 2; ++hlf) { const int c0 = hlf * 512 + lane * 8; const f32x4 w0 = *(const f32x4*)(fw + c0), w1 = *(const f32x4*)(fw + c0 + 4);
                    f32x4 o0 = {v[hlf * 8 + 0] * rstd * w0[0], v[hlf * 8 + 1] * rstd * w0[1], v[hlf * 8 + 2] * rstd * w0[2], v[hlf * 8 + 3] * rstd * w0[3]};
                    f32x4 o1 = {v[hlf * 8 + 4] * rstd * w1[0], v[hlf * 8 + 5] * rstd * w1[1], v[hlf * 8 + 6] * rstd * w1[2], v[hlf * 8 + 7] * rstd * w1[3]};
                    *(f32x4*)(orow + c0) = o0; *(f32x4*)(orow + c0 + 4) = o1; } }
        } else if (ph > 0 && ph < 1 + 6 * DEPTH) {
            const int layer = (ph - 1) / 6, kind = (ph - 1) % 6;
            if (kind == 0 && PHM(0)) {
                LAS float* scr = (LAS float*)(ldsl + wave * 8448);
                constexpr int I0 = 16 * 64, IF = 192, I2 = 6 * 24, I3 = 4 * 32, I4 = 16 * 32;
                for (int it = gw; it < IF + I0 + I2 + I3 + I4; it += NGW) { int r = it;
                    if (r < IF) {
                        const float* w_in_l = a.w_in + (size_t)layer * DM * DIN; const float* nw = a.norm_w + layer * DM; const int kb = r & 15, part = r >> 4;
                        if (part < 4) fold_item(w_in_l, nw, a.pool_w + (size_t)(layer * 4 + part) * 4096, a.pool_scale[layer * 256 + part * 64 + lane], 512 + part * 64, WN, 1024 + part * 64, kb * 64, lane);
                        else { const int pp = part - 4, hh = pp & 3, sn = pp >> 2;
                            fold_item(w_in_l, nw, (sn ? SWF : CWF) + (size_t)(layer * 4 + hh) * 4096, 1.f, hh * 64, WF, sn * 256 + hh * 64, kb * 64, lane); }
                        continue; } r -= IF;
                    if (r < I0) { if ((r & 63) < 32 || (r & 63) >= 40) prep_item(a, layer, 0, 1024, WN, r, 64, scr, lane); continue; } r -= I0;
                    if (r < I2) { prep_item(a, layer, 2, 384, WQ, r, 24, scr, lane); continue; } r -= I2;
                    if (r < I3) { prep_item(a, layer, 3, 256, WKV, r, 32, scr, lane); continue; } r -= I3;
                    prep_item(a, layer, 4, 1024, WO, r, 32, scr, lane); }
                if (layer == 0) {
                    for (int r0 = gw * 4; r0 < MTOK; r0 += NGW * 4) {
                        f32x4 v[4][4]; float ss[4];
#pragma unroll
                        for (int q = 0; q < 4; ++q) { const int r = r0 + q; const int b = r / L, l = r - b * L;
                            const float* src = l < NMETA ? a.meta + (size_t)l * DM : a.x + ((size_t)b * SEQ + l - NMETA) * DM;
                            const f32x4* xr = (const f32x4*)src + lane;
#pragma unroll
                            for (int j = 0; j < 4; ++j) v[q][j] = xr[64 * j]; }
#pragma unroll
                        for (int q = 0; q < 4; ++q) { float t = 0.f;
#pragma unroll
                            for (int j = 0; j < 4; ++j) t += v[q][j].x * v[q][j].x + v[q][j].y * v[q][j].y + v[q][j].z * v[q][j].z + v[q][j].w * v[q][j].w;
                            ss[q] = t; }
#pragma unroll
                        for (int o = 1; o < 64; o <<= 1) {
#pragma unroll
                            for (int q = 0; q < 4; ++q) ss[q] += __uint_as_float((unsigned)__builtin_amdgcn_ds_bpermute((lane ^ o) << 2, (int)__float_as_uint(ss[q]))); }
#pragma unroll
                        for (int q = 0; q < 4; ++q) { const int r = r0 + q;
                            if (lane == 0) RH[r] = rsqrtf(ss[q] * (1.f / DM) + NORM_EPS);
                            u32x2* o8 = (u32x2*)(H + (size_t)r * DM) + lane;
#pragma unroll
                            for (int j = 0; j < 4; ++j) { u32x2 w; w.x = cvt_pk_bf16(v[q][j].x, v[q][j].y); w.y = cvt_pk_bf16(v[q][j].z, v[q][j].w); o8[64 * j] = w; } }
                    }
                } else {
                    for (int r0 = gw * 8; r0 < MTOK; r0 += NGW * 8) {
                        u32x4 v[8][2]; float ss[8];
#pragma unroll
                        for (int q = 0; q < 8; ++q) { const u32x4* xr = (const u32x4*)(H + (size_t)(r0 + q) * DM) + lane; v[q][0] = xr[0]; v[q][1] = xr[64]; }
#pragma unroll
                        for (int q = 0; q < 8; ++q) { float t = 0.f;
#pragma unroll
                            for (int j = 0; j < 2; ++j) { const u32x4 x = v[q][j]; float e;
                                e = bf_lo(x.x); t += e * e; e = bf_hi(x.x); t += e * e; e = bf_lo(x.y); t += e * e; e = bf_hi(x.y); t += e * e;
                                e = bf_lo(x.z); t += e * e; e = bf_hi(x.z); t += e * e; e = bf_lo(x.w); t += e * e; e = bf_hi(x.w); t += e * e; }
                            ss[q] = t; }
#pragma unroll
                        for (int o = 1; o < 64; o <<= 1) {
#pragma unroll
                            for (int q = 0; q < 8; ++q) ss[q] += __uint_as_float((unsigned)__builtin_amdgcn_ds_bpermute((lane ^ o) << 2, (int)__float_as_uint(ss[q]))); }
                        if (lane < 8) { float sv = ss[0];
#pragma unroll
                            for (int q = 1; q < 8; ++q) sv = (lane == q) ? ss[q] : sv;
                            RH[r0 + lane] = rsqrtf(sv * (1.f / DM) + NORM_EPS); }
                    }
                }
            } else if ((kind == 1 || kind == 3 || kind == 5) && PHM(1)) {
                const int j0 = kind == 1 ? 0 : (kind == 3 ? 2 : 5), j1 = kind == 1 ? 2 : (kind == 3 ? 5 : 6);
                if (kind == 5) {
                    const float* PART = (const float*)(ws + WS_PART);
                    for (int gi = bx * 512 + tid; gi < 64 * 16 * 128; gi += G * 512) { const int col = gi & 127, row = (gi >> 7) & 15, bh = gi >> 11; constexpr float C = att::SCALE * 1.4426950408889634f;
                        const float* p0 = PART + (size_t)(bh * 4) * PART_STRIDE; float m = -1e30f;
#pragma unroll
                        for (int q = 0; q < 4; ++q) m = fmaxf(m, p0[q * PART_STRIDE + 2048 + row]);
                        float lsum = 0.f, osum = 0.f;
#pragma unroll
                        for (int q = 0; q < 4; ++q) { const float w = __builtin_amdgcn_exp2f((p0[q * PART_STRIDE + 2048 + row] - m) * C); lsum += p0[q * PART_STRIDE + 2064 + row] * w; osum += p0[q * PART_STRIDE + row * 128 + col] * w; }
                        const size_t t = (size_t)(bh >> 2) * L + 4096 + row; const int c = (bh & 3) * 128 + col;
                        const float ov = osum / lsum * bf1(U[t * UW + U_AG + c]); MIX[t * DM + 512 + c] = (bf16_t)(cvt_pk_bf16(ov, ov) & 0xffffu); }
                    asm volatile("s_waitcnt vmcnt(0) lgkmcnt(0)" ::: "memory");
                    xcd_barrier((unsigned*)(ws + WS_BAR), (volatile LAS unsigned*)(ldsl + 135168), tid == 0);
                }
#pragma unroll 1
                for (int jb = j0; jb < j1; ++jb) {
                    pg8::Gemm g;
                    if (jb == 0)      g = pg8::Gemm{H, WN, MTOK, UW, DM, DM, DM};
                    else if (jb == 1) g = pg8::Gemm{WF, H, 512, MTOK, DM, DM, DM};
                    else if (jb == 2) g = pg8::Gemm{DFT, XT, 4096, 4096, KF, KF, KD};
                    else if (jb == 3) g = pg8::Gemm{U + U_CQ, WQ, MTOK, QW, 384, UW, 384};
                    else if (jb == 4) g = pg8::Gemm{U + U_CKV, WKV, MTOK, KVW, 256, UW, 256};
                    else              g = pg8::Gemm{MIX, WO, MTOK, DM, DM, DM, DM};
                    const int rot = (jb == 1 || jb == 4) ? 8 : (jb == 3 ? 16 : 0);
                    pg8::StaticOrder S; S.init(g.M, g.N, G, (bx + G - rot) % G); EpiAll E{jb, ws};
                    pg8::gemm_phase<EpiAll>(ldsl, g, S, E, wave_s);
                    if (jb == 2) {
                for (int it = vcu; it < 256; it += G) {
                    const int fr = lane & 15, fq = lane >> 4;
                    const bf16_t* ap = DFT + (size_t)(4096 + fr) * KF + wave * 544 + fq * 8;
                    const bf16_t* bp = XT + (size_t)(it * 16 + fr) * KD + wave * 544 + fq * 8;
                    const float z0 = opaque_zero(); f32x4 c = {z0, z0, z0, z0};
#pragma unroll
                    for (int s0 = 0; s0 < 18; s0 += 6) { bf16x8 av[6], bv[6];
#pragma unroll
                        for (int e = 0; e < 6; ++e) if (s0 + e < 17) { av[e] = *(const bf16x8*)(ap + (s0 + e) * 32); bv[e] = *(const bf16x8*)(bp + (s0 + e) * 32); }
#pragma unroll
                        for (int e = 0; e < 6; ++e) if (s0 + e < 17) c = __builtin_amdgcn_mfma_f32_16x16x32_bf16(av[e], bv[e], c, 0, 0, 0); }
                    float* red = (float*)lds;
                    __syncthreads();
#pragma unroll
                    for (int j = 0; j < 4; ++j) red[wave * 256 + (fq * 4 + j) * 16 + fr] = c[j];
                    __syncthreads();
                    if (tid < 256) { float s = 0.f;
#pragma unroll
                        for (int w = 0; w < 8; ++w) s += red[w * 256 + tid];
                        const int kr = tid >> 4, cc = it * 16 + (tid & 15), b = cc >> 8, n = cc & 255; const size_t tok = (size_t)b * L + 4096 + kr;
                        const float gt = bf1(U[tok * UW + U_FG + n]);
                        { const float sv = s * gt; MIX[tok * DM + n] = (bf16_t)(cvt_pk_bf16(sv, sv) & 0xffffu); } }
                    __syncthreads();
                }
                    }
                }
            } else if (kind == 2 && PHM(2)) {
                for (int pr = gw; pr < MTOK / 2; pr += NGW) {
                    const int t0 = pr * 2;
#pragma unroll
                    for (int q = 0; q < 2; ++q) { const bf16_t* row = U + (size_t)(t0 + q) * UW;
                        const u32x4 x = *(const u32x4*)(row + lane * 8); float sq = 0.f, sk = 0.f;
                        if (lane < 48) { float e; e = bf_lo(x.x); sq += e * e; e = bf_hi(x.x); sq += e * e; e = bf_lo(x.y); sq += e * e; e = bf_hi(x.y); sq += e * e;
                                         e = bf_lo(x.z); sq += e * e; e = bf_hi(x.z); sq += e * e; e = bf_lo(x.w); sq += e * e; e = bf_hi(x.w); sq += e * e; }
                        if (lane < 32) { const u32x4 y = *(const u32x4*)(row + U_CKV + lane * 8); float e;
                                         e = bf_lo(y.x); sk += e * e; e = bf_hi(y.x); sk += e * e; e = bf_lo(y.y); sk += e * e; e = bf_hi(y.y); sk += e * e;
                                         e = bf_lo(y.z); sk += e * e; e = bf_hi(y.z); sk += e * e; e = bf_lo(y.w); sk += e * e; e = bf_hi(y.w); sk += e * e; }
                        sq = wave_sum(sq); sk = wave_sum(sk);
                        if (lane == 0) { RQ[t0 + q] = rsqrtf(sq * (1.f / 384.f) + NORM_EPS); RKV[t0 + q] = rsqrtf(sk * (1.f / 256.f) + NORM_EPS); } }
                    const int t = t0 + (lane >> 5), cgp = lane & 31, b = t / L, l = t - b * L, gI = cgp >> 3, half = 1 << gI;
                    const int lo = max(l - half, 0), hi = min(l + half, L);
                    float s[8] = {0.f, 0.f, 0.f, 0.f, 0.f, 0.f, 0.f, 0.f};
                    const bf16_t* base = U + (size_t)b * L * UW + U_PP + cgp * 8;
                    u32x4 xw[16];
#pragma unroll
                    for (int i = 0; i < 16; ++i) { int tt = l - 8 + i; tt = tt < 0 ? 0 : (tt > L - 1 ? L - 1 : tt); xw[i] = *(const u32x4*)(base + (size_t)tt * UW); }
#pragma unroll
                    for (int i = 0; i < 16; ++i) { const int tt = l - 8 + i; const float wgt = (tt >= lo && tt < hi) ? 1.f : 0.f; const u32x4 x = xw[i];
                        s[0] += wgt * bf_lo(x.x); s[1] += wgt * bf_hi(x.x); s[2] += wgt * bf_lo(x.y); s[3] += wgt * bf_hi(x.y); s[4] += wgt * bf_lo(x.z); s[5] += wgt * bf_hi(x.z); s[6] += wgt * bf_lo(x.w); s[7] += wgt * bf_hi(x.w); }
                    const float ic = 1.f / (float)(hi - lo);
                    const u32x4 xs = *(const u32x4*)(base + (size_t)l * UW); const u32x4 gt = *(const u32x4*)(U + (size_t)t * UW + U_PG + cgp * 8);
                    float y[8];
                    y[0] = (s[0] * ic - bf_lo(xs.x)) * bf_lo(gt.x); y[1] = (s[1] * ic - bf_hi(xs.x)) * bf_hi(gt.x);
                    y[2] = (s[2] * ic - bf_lo(xs.y)) * bf_lo(gt.y); y[3] = (s[3] * ic - bf_hi(xs.y)) * bf_hi(gt.y);
                    y[4] = (s[4] * ic - bf_lo(xs.z)) * bf_lo(gt.z); y[5] = (s[5] * ic - bf_hi(xs.z)) * bf_hi(gt.z);
                    y[6] = (s[6] * ic - bf_lo(xs.w)) * bf_lo(gt.w); y[7] = (s[7] * ic - bf_hi(xs.w)) * bf_hi(gt.w);
                    u32x4 o; o.x = cvt_pk_bf16(y[0], y[1]); o.y = cvt_pk_bf16(y[2], y[3]); o.z = cvt_pk_bf16(y[4], y[5]); o.w = cvt_pk_bf16(y[6], y[7]);
                    *(u32x4*)(MIX + (size_t)t * DM + 256 + cgp * 8) = o;
                }
                { bf16_t* rowl = (bf16_t*)(lds + wave * 16896);
                  for (int r = gw; r < 4096; r += NGW) { bf16_t* xr = XT + (size_t)r * KD;
                      { u32x4 tmpv[17];
#pragma unroll
                        for (int it = 0; it < 17; ++it) { const int c = lane + 64 * it; if (c < KD / 8) tmpv[it] = *(const u32x4*)(xr + c * 8); }
#pragma unroll
                        for (int it = 0; it < 17; ++it) { const int c = lane + 64 * it; if (c < KD / 8) *(u32x4*)(rowl + c * 8) = tmpv[it]; } }
                      asm volatile("s_waitcnt vmcnt(0) lgkmcnt(0)" ::: "memory");
                      for (int c = lane; c < KF / 8; c += 64) { const int c0 = c * 8, hs = c0 >= LF, l0 = c0 - hs * LF; const bf16_t* hb = rowl + hs * LP; float v[8];
#pragma unroll
                          for (int e = 0; e < 8; ++e) { const int l = l0 + e; float x = 0.f;
                              if (l <= LH) { x = bf1(hb[l]); if (l > 0 && l < LH) { const float y = bf1(hb[L - l]); x = hs ? x - y : x + y; } else if (hs) x = 0.f; }
                              v[e] = x; }
                          u32x4 o; o.x = cvt_pk_bf16(v[0], v[1]); o.y = cvt_pk_bf16(v[2], v[3]); o.z = cvt_pk_bf16(v[4], v[5]); o.w = cvt_pk_bf16(v[6], v[7]);
                          *(u32x4*)(xr + c0) = o; }
                      asm volatile("s_waitcnt vmcnt(0) lgkmcnt(0)" ::: "memory"); } }
            } else if (kind == 4 && PHM(4)) {
                float* PART = (float*)(ws + WS_PART);
                for (int i = 0;; ++i) { const int uidx = i * G + vcu; if (uidx >= 1024 + 256) break;
                    if (uidx < 1024) { const int bh = uidx >> 4, qb = uidx & 15; att::attn_unit(bh >> 2, bh & 3, qb, Qb, KVb, U, MIX, (char*)lds, ldsl, 0, att::NT, nullptr, wave_s); }
                    else { const int v = uidx - 1024, bh = v >> 2, q = v & 3;
                        const int tb = q < 2 ? 17 * q : 34 + 16 * (q - 2), te = q < 2 ? tb + 17 : (q == 2 ? tb + 16 : att::NT);
                        att::attn_unit(bh >> 2, bh & 3, 16, Qb, KVb, U, MIX, (char*)lds, ldsl, tb, te, PART + (size_t)v * PART_STRIDE, wave_s); } }
                __syncthreads();
            }
        }
    }
        asm volatile("s_waitcnt vmcnt(0) lgkmcnt(0)" ::: "memory");
        if (ph + 1 < a.ph_hi) {
            if (ph == a.ph_lo) grid.sync();
            else xcd_barrier((unsigned*)(ws + WS_BAR), (volatile LAS unsigned*)(ldsl + 135168), tid == 0);
        }
    }
}


#ifndef N_LAUNCH_SPLIT
#define N_LAUNCH_SPLIT 0
#endif
extern "C" void kernel_launch(void* const* d_in, const int* in_sizes, int n_in, void* d_out, int out_size, void* d_ws, size_t ws_size, hipStream_t stream) {
    static int grid = 0;
    if (grid == 0) {
        if (n_in != 13 || in_sizes[0] != NB * SEQ * DM || out_size != NB * SEQ * DM || ws_size < WS_END + 256) {
            fprintf(stderr, "kernel_launch: shape/workspace mismatch: n_in %d in0 %d out %d ws %zu (need %zu)\n", n_in, n_in > 0 ? in_sizes[0] : -1, out_size, ws_size, (size_t)WS_END); grid = -1; return; }
        int dev = 0, cus = 0, per_cu = 0;
        hipGetDevice(&dev); hipDeviceGetAttribute(&cus, hipDeviceAttributeMultiprocessorCount, dev);
        if (hipFuncSetAttribute((const void*)hymba_fwd, hipFuncAttributeMaxDynamicSharedMemorySize, LDS_BYTES) != hipSuccess) { fprintf(stderr, "kernel_launch: hipFuncSetAttribute failed\n"); grid = -1; return; }
        if (hipOccupancyMaxActiveBlocksPerMultiprocessor(&per_cu, (const void*)hymba_fwd, 512, LDS_BYTES) != hipSuccess || per_cu < 1) { fprintf(stderr, "kernel_launch: occupancy query gave %d\n", per_cu); per_cu = 1; }
        (void)hipGetLastError();
        grid = cus;
    }
    if (grid < 0) return;
    Args a{};
    a.x = (const float*)d_in[0]; a.meta = (const float*)d_in[1]; a.norm_w = (const float*)d_in[2]; a.w_in = (const float*)d_in[3]; a.fourier_w = (const float*)d_in[4];
    a.pool_w = (const float*)d_in[5]; a.pool_scale = (const float*)d_in[6]; a.q_norm_w = (const float*)d_in[7]; a.w_uq = (const float*)d_in[8]; a.kv_norm_w = (const float*)d_in[9];
    a.w_ukv = (const float*)d_in[10]; a.w_out = (const float*)d_in[11]; a.final_norm_w = (const float*)d_in[12];
    a.out = (float*)d_out; a.ws = (unsigned char*)d_ws;
    constexpr int NPH = 2 + 6 * DEPTH;
#if N_LAUNCH_SPLIT
    for (int p = 0; p < NPH; ++p) { a.ph_lo = p; a.ph_hi = p + 1; void* args[] = {&a};
        hipError_t e = hipLaunchCooperativeKernel((void*)hymba_fwd, dim3(grid), dim3(512), args, LDS_BYTES, stream);
        if (e != hipSuccess) { fprintf(stderr, "cooperative launch failed: %s\n", hipGetErrorString(e)); break; } }
#else
    (void)hipMemsetAsync((char*)d_ws + WS_BAR, 0, (size_t)XCD_BAR_WORDS * 4, stream);
    a.ph_lo = 0; a.ph_hi = NPH; void* args[] = {&a};
    hipError_t e = hipLaunchCooperativeKernel((void*)hymba_fwd, dim3(grid), dim3(512), args, LDS_BYTES, stream);
    if (e != hipSuccess) fprintf(stderr, "cooperative launch failed: %s (grid %d)\n", hipGetErrorString(e), grid);
#endif
}
```

```cpp
#include <hip/hip_runtime.h>
#include <hip/hip_cooperative_groups.h>
#include <cstdio>
#include <cstdint>
namespace cg = cooperative_groups;

#define LAS __attribute__((address_space(3)))
typedef unsigned short bf16_t;
typedef short bf16x8 __attribute__((ext_vector_type(8)));
typedef short s16x4 __attribute__((ext_vector_type(4)));
typedef float f32x4 __attribute__((ext_vector_type(4)));
typedef float f32x8 __attribute__((ext_vector_type(8)));
typedef float f32x16 __attribute__((ext_vector_type(16)));
typedef unsigned u32x4 __attribute__((ext_vector_type(4)));
typedef unsigned u32x2 __attribute__((ext_vector_type(2)));

constexpr int DM = 1024, NB = 16, SEQ = 4096, NMETA = 16, L = SEQ + NMETA, MTOK = NB * L, DEPTH = 4;
constexpr int DIN = 2240, UW = 2048;
constexpr int LP = 4224, KD = 2 * LP;
constexpr int LH = L / 2, LF = 2176, KF = 2 * LF;
constexpr int QW = 768, KVW = 1024;
constexpr float NORM_EPS = 1e-6f;
constexpr int U_CQ = 0, U_KR = 384, U_CKV = 512, U_FG = 768, U_PP = 1024, U_PG = 1280, U_AG = 1536;

constexpr size_t al256(size_t x) { return (x + 255) / 256 * 256; }
constexpr size_t WS_H = 0;
constexpr size_t WS_RH = WS_H + al256((size_t)MTOK * DM * 2);
constexpr size_t WS_HN = WS_RH + al256((size_t)MTOK * 4);
constexpr size_t WS_U = WS_HN + al256((size_t)MTOK * DM * 2);
constexpr size_t WS_XT = WS_U + al256((size_t)MTOK * UW * 2);
constexpr size_t WS_DFT = WS_XT + al256((size_t)4096 * KD * 2);
constexpr size_t WS_Q = WS_DFT + al256((size_t)L * KF * 2);
constexpr size_t WS_KV = WS_Q + al256((size_t)MTOK * QW * 2);
constexpr size_t WS_WN = WS_KV + al256((size_t)MTOK * KVW * 2);
constexpr size_t WS_WF = WS_WN + al256((size_t)UW * DM * 2);
constexpr size_t WS_WQ = WS_WF + al256((size_t)512 * DM * 2);
constexpr size_t WS_WKV = WS_WQ + al256((size_t)768 * 384 * 2);
constexpr size_t WS_WO = WS_WKV + al256((size_t)1024 * 256 * 2);
constexpr size_t WS_RQ = WS_WO + al256((size_t)1024 * 1024 * 2);
constexpr size_t WS_RKV = WS_RQ + al256((size_t)MTOK * 4);
constexpr size_t WS_COS = WS_RKV + al256((size_t)MTOK * 4);
constexpr size_t WS_SIN = WS_COS + al256((size_t)L * 32 * 4);
constexpr size_t WS_CWF = WS_SIN + al256((size_t)L * 32 * 4);
constexpr size_t WS_SWF = WS_CWF + al256((size_t)DEPTH * 4 * 64 * 64 * 4);
constexpr size_t WS_PART = WS_SWF + al256((size_t)DEPTH * 4 * 64 * 64 * 4);
constexpr int PART_STRIDE = 16 * 128 + 32;
constexpr size_t WS_BAR = WS_PART + al256((size_t)256 * PART_STRIDE * 4);
constexpr size_t WS_END = WS_BAR + al256((size_t)3456 * 4);

constexpr int LDS_BYTES = 131072 + 4096 + 64;

__device__ __forceinline__ unsigned cvt_pk_bf16(float lo, float hi) { unsigned r; asm volatile("v_cvt_pk_bf16_f32 %0, %1, %2" : "=v"(r) : "v"(lo), "v"(hi)); return r; }
__device__ __forceinline__ int opaque_tid_w(int wave_s) { int t; asm volatile("v_mbcnt_lo_u32_b32 %0, -1, 0\n\tv_mbcnt_hi_u32_b32 %0, -1, %0" : "=&v"(t)); return (wave_s << 6) | t; }
__device__ __forceinline__ float opaque_zero() { float z; asm volatile("v_mov_b32 %0, 0" : "=v"(z)); return z; }
__device__ __forceinline__ float bf_lo(unsigned w) { return __uint_as_float(w << 16); }
__device__ __forceinline__ float bf_hi(unsigned w) { return __uint_as_float(w & 0xffff0000u); }
__device__ __forceinline__ float bf1(bf16_t x) { return __uint_as_float((unsigned)x << 16); }
__device__ __forceinline__ float wave_sum_l(float v, int lane) {
#pragma unroll
    for (int o = 1; o < 64; o <<= 1) v += __uint_as_float((unsigned)__builtin_amdgcn_ds_bpermute((lane ^ o) << 2, (int)__float_as_uint(v)));
    return v;
}
#define wave_sum(v) wave_sum_l((v), lane)
__device__ __forceinline__ float silu_f(float x) { return x * __builtin_amdgcn_rcpf(1.f + __expf(-x)); }
__device__ __forceinline__ u32x4 pack8(f32x4 a, f32x4 b) { u32x4 w; w.x = cvt_pk_bf16(a[0], a[1]); w.y = cvt_pk_bf16(a[2], a[3]); w.z = cvt_pk_bf16(b[0], b[1]); w.w = cvt_pk_bf16(b[2], b[3]); return w; }
__device__ __forceinline__ int rope_src(int jj) { const int g = jj >> 3, e = jj & 7; return e < 4 ? 4 * g + e : 28 + 4 * g + e; }

namespace pg8 {
constexpr int BM = 256, BK = 64, HALF = 128, HTB = HALF * BK * 2, NXCD = 8, WGM = 8;
__host__ __device__ __forceinline__ int lds_byte(int r, int c) { const int st = (r >> 4) * 2 + (c >> 5), rr = r & 15, cc = c & 31, ob = rr * 64 + cc * 2; return st * 1024 + (ob ^ (((ob >> 9) & 1) << 5)); }
__host__ __device__ __forceinline__ void stage_rc(int b, int& R, int& C) { const int st = b / 1024, sb = b % 1024, swz = sb ^ (((sb >> 9) & 1) << 5); R = (st >> 1) * 16 + swz / 64; C = (st & 1) * 32 + (swz % 64) / 2; }
__host__ __device__ __forceinline__ int perm32(int rho) { const int n = rho >> 4, i = rho & 15; return 8 * (i >> 2) + 4 * n + (i & 3); }
struct Unit { int pm, pn; };
struct Gemm { const bf16_t* A; const bf16_t* Bt; int M, N, K, lda, ldb; };
struct StaticOrder {
    int nM, nN, nwg, G, c;
    __device__ void init(int M, int N, int G_, int c_) { nM = M / BM; nN = N / BM; nwg = nM * nN; G = G_; c = c_; }
    __device__ bool next(int i, Unit& u) const {
        const long Lx = (long)i * G + c; if (Lx >= nwg) return false;
        int wgid = (int)Lx; { const int q = nwg / NXCD, r = nwg % NXCD, xcd = wgid % NXCD, off = wgid / NXCD; wgid = (xcd < r ? xcd * (q + 1) : r * (q + 1) + (xcd - r) * q) + off; }
        const int nig = WGM * nN, gid = wgid / nig, fm = gid * WGM, gsz = (nM - fm) < WGM ? (nM - fm) : WGM;
        u.pm = fm + ((wgid % nig) % gsz); u.pn = (wgid % nig) / gsz; return true;
    }
};
template <class Epi>
__device__ __forceinline__ void gemm_phase(LAS unsigned char* lds, const Gemm g, const StaticOrder& S, const Epi& E, int wave_s) {
    const int tid = opaque_tid_w(wave_s), wid = __builtin_amdgcn_readfirstlane(tid >> 6), lane = tid & 63, wr = wid >> 2, wc = wid & 3, fr = lane & 15, fq = lane >> 4;
    const int K = g.K, nt = K / BK;
    unsigned voffA[2], voffB[2];
#pragma unroll
    for (int i = 0; i < 2; ++i) { int R, C; stage_rc(tid * 16 + i * 8192, R, C); const int Rb = (R & ~31) + perm32(R & 31);
        voffA[i] = (unsigned)(R * g.lda + C) * 2u; voffB[i] = (unsigned)(Rb * g.ldb + C) * 2u; }
    const size_t kstep = (size_t)(BK * 2);
    const size_t hstepA = (size_t)HALF * g.lda * 2, hstepB = (size_t)HALF * g.ldb * 2;
    const size_t tstepA = 2 * hstepA, tstepB = 2 * hstepB;
    const unsigned ldsw = (unsigned)wid * 1024u;
    const int aoff = lds_byte(wr * 64 + fr, fq * 8), boff = lds_byte(wc * 32 + fr, fq * 8);
#define PG8_SA(b, h) (((b) * 2 + (h)) * HTB)
#define PG8_SB(b, h) ((4 + (b) * 2 + (h)) * HTB)
#define PG8_STAGE(bufoff, gbase, voff) do { _Pragma("unroll") for (int _i = 0; _i < 2; ++_i) \
        __builtin_amdgcn_global_load_lds((const unsigned*)((const char*)(gbase) + (voff)[_i]), (LAS unsigned*)(lds + (bufoff) + ldsw + _i * 8192), 16, 0, 0); } while (0)
#define PG8_LDA(dst, b, h) do { _Pragma("unroll") for (int m = 0; m < 4; ++m) _Pragma("unroll") for (int k = 0; k < 2; ++k) dst[m][k] = *(const LAS bf16x8*)(lds + PG8_SA(b, h) + aoff + m * 2048 + k * 1024); } while (0)
#define PG8_LDB(dst, b, h) do { _Pragma("unroll") for (int n = 0; n < 2; ++n) _Pragma("unroll") for (int k = 0; k < 2; ++k) dst[n][k] = *(const LAS bf16x8*)(lds + PG8_SB(b, h) + boff + n * 2048 + k * 1024); } while (0)
#define PG8_MMA(ai, bj, At, Bt) do { __builtin_amdgcn_s_setprio(1); _Pragma("unroll") for (int m = 0; m < 4; ++m) _Pragma("unroll") for (int n = 0; n < 2; ++n) _Pragma("unroll") for (int k = 0; k < 2; ++k) \
        acc[ai][bj][m][n] = __builtin_amdgcn_mfma_f32_16x16x32_bf16(Bt[n][k], At[m][k], acc[ai][bj][m][n], 0, 0, 0); __builtin_amdgcn_s_setprio(0); } while (0)
#define PG8_WAIT_V(n) asm volatile("s_waitcnt vmcnt(" #n ")" ::: "memory")
#define PG8_WAIT_L(n) asm volatile("s_waitcnt lgkmcnt(" #n ")" ::: "memory")
#define PG8_BAR __builtin_amdgcn_s_barrier()
#define PG8_SCHED __builtin_amdgcn_sched_barrier(0)
    Unit cur, nxt; int ui = 0;
    if (!S.next(0, cur)) return;
    f32x4 acc[2][2][4][2];
#pragma unroll
    for (int a = 0; a < 2; ++a)
#pragma unroll
        for (int b = 0; b < 2; ++b)
#pragma unroll
            for (int m = 0; m < 4; ++m)
#pragma unroll
                for (int n = 0; n < 2; ++n) { float z; asm volatile("v_mov_b32 %0, 0" : "=v"(z)); acc[a][b][m][n] = (f32x4){z, z, z, z}; }
    bf16x8 At[4][2], B0[2][2], B1[2][2];
    const char* cA = (const char*)g.A + (size_t)cur.pm * tstepA; const char* cB = (const char*)g.Bt + (size_t)cur.pn * tstepB;
    PG8_STAGE(PG8_SB(0, 0), cB, voffB); PG8_STAGE(PG8_SB(0, 1), cB + hstepB, voffB); PG8_STAGE(PG8_SA(0, 0), cA, voffA); PG8_STAGE(PG8_SA(0, 1), cA + hstepA, voffA);
    if (wr == 1) PG8_BAR;
    PG8_WAIT_V(2); PG8_BAR;
    PG8_STAGE(PG8_SB(1, 0), cB + kstep, voffB); PG8_STAGE(PG8_SA(1, 0), cA + kstep, voffA); PG8_STAGE(PG8_SB(1, 1), cB + hstepB + kstep, voffB);
    PG8_WAIT_V(6); PG8_BAR;
    for (;;) {
        const bool has_next = S.next(ui + 1, nxt);
        const char* nA = has_next ? (const char*)g.A + (size_t)nxt.pm * tstepA : cA; const char* nB = has_next ? (const char*)g.Bt + (size_t)nxt.pn * tstepB : cB;
#pragma unroll 1
        for (int t = 0; t < nt; t += 2) {
            const bool last = (t == nt - 2);
            const char* a1 = cA + (size_t)(t + 1) * kstep;
            const char* a2 = last ? nA : cA + (size_t)(t + 2) * kstep; const char* b2 = last ? nB : cB + (size_t)(t + 2) * kstep;
            const char* a3 = a2 + kstep; const char* b3 = b2 + kstep;
            PG8_LDB(B0, 0, 0); PG8_LDB(B1, 0, 1); PG8_SCHED; PG8_LDA(At, 0, 0); PG8_STAGE(PG8_SA(1, 1), a1 + hstepA, voffA);
            PG8_WAIT_V(8); PG8_WAIT_L(0); PG8_BAR; PG8_MMA(0, 0, At, B0); PG8_MMA(0, 1, At, B1); PG8_BAR; PG8_SCHED;
            PG8_LDA(At, 0, 1); PG8_STAGE(PG8_SB(0, 0), b2, voffB); PG8_STAGE(PG8_SB(0, 1), b2 + hstepB, voffB); PG8_STAGE(PG8_SA(0, 0), a2, voffA);
            PG8_WAIT_V(8); PG8_WAIT_L(0); PG8_BAR; PG8_MMA(1, 0, At, B0); PG8_MMA(1, 1, At, B1); PG8_BAR; PG8_SCHED;
            PG8_LDB(B0, 1, 0); PG8_LDB(B1, 1, 1); PG8_SCHED; PG8_LDA(At, 1, 0); PG8_STAGE(PG8_SA(0, 1), a2 + hstepA, voffA);
            PG8_WAIT_V(8); PG8_WAIT_L(0); PG8_BAR; PG8_MMA(0, 0, At, B0); PG8_MMA(0, 1, At, B1); PG8_BAR; PG8_SCHED;
            PG8_LDA(At, 1, 1); PG8_STAGE(PG8_SB(1, 0), b3, voffB); PG8_STAGE(PG8_SB(1, 1), b3 + hstepB, voffB); PG8_STAGE(PG8_SA(1, 0), a3, voffA);
            PG8_WAIT_V(8); PG8_WAIT_L(0); PG8_BAR; PG8_MMA(1, 0, At, B0); PG8_MMA(1, 1, At, B1); PG8_BAR; PG8_SCHED;
        }
        if (wr == 0) PG8_BAR;
        E(acc, cur, wr, wc, fr, fq);
        if (!has_next) break;
#pragma unroll
        for (int a = 0; a < 2; ++a)
#pragma unroll
            for (int b = 0; b < 2; ++b)
#pragma unroll
                for (int m = 0; m < 4; ++m)
#pragma unroll
                    for (int n = 0; n < 2; ++n) { float z; asm volatile("v_mov_b32 %0, 0" : "=v"(z)); acc[a][b][m][n] = (f32x4){z, z, z, z}; }
        cur = nxt; cA = nA; cB = nB; ++ui;
        if (wr == 1) PG8_BAR;
    }
    PG8_WAIT_V(0);
    PG8_BAR;
#undef PG8_SA
#undef PG8_SB
#undef PG8_STAGE
#undef PG8_LDA
#undef PG8_LDB
#undef PG8_MMA
#undef PG8_WAIT_V
#undef PG8_WAIT_L
#undef PG8_BAR
#undef PG8_SCHED
}
}
using pg8::Unit;
typedef const f32x4 (&AccRef)[2][2][4][2];

__device__ __forceinline__ void rope8(f32x4& v0, f32x4& v1, const float* cs, const float* sn, int pos, int g) {
    const f32x4 c = *(const f32x4*)(cs + pos * 32 + 4 * g), s = *(const f32x4*)(sn + pos * 32 + 4 * g);
    const f32x4 a = v0 * c - v1 * s, b = v1 * c + v0 * s; v0 = a; v1 = b;
}
struct EpiU {
    bf16_t* U; const float* cs; const float* sn; const float* rh;
    __device__ __forceinline__ void operator()(AccRef acc, const Unit& u, int wr, int wc, int fr, int fq) const {
        const int row0 = u.pm * 256 + wr * 64 + fr;
        float rsv[2][4];
#pragma unroll
        for (int ai = 0; ai < 2; ++ai)
#pragma unroll
            for (int m = 0; m < 4; ++m) rsv[ai][m] = rh[row0 + ai * 128 + m * 16];
#pragma unroll
        for (int bj = 0; bj < 2; ++bj) {
            const int blk = u.pn * 256 + bj * 128 + wc * 32, col0 = blk + 8 * fq;
            const bool dosilu = blk >= U_FG && !(blk >= U_PP && blk < U_PG);
            const bool dorope = blk >= U_KR && blk < U_KR + 64;
#pragma unroll
            for (int ai = 0; ai < 2; ++ai)
#pragma unroll
                for (int m = 0; m < 4; ++m) {
                    const int row = row0 + ai * 128 + m * 16;
                    f32x4 v0 = acc[ai][bj][m][0] * rsv[ai][m], v1 = acc[ai][bj][m][1] * rsv[ai][m];
                    if (dorope) rope8(v0, v1, cs, sn, row % L, (col0 - U_KR) >> 3);
                    if (dosilu) {
#pragma unroll
                        for (int e = 0; e < 4; ++e) { v0[e] = silu_f(v0[e]); v1[e] = silu_f(v1[e]); }
                    }
                    *(u32x4*)(U + (size_t)row * UW + col0) = pack8(v0, v1);
                    __builtin_amdgcn_sched_barrier(0);
                }
        }
    }
};
struct EpiXT {
    bf16_t* XT; const float* rh;
    __device__ __forceinline__ void operator()(AccRef acc, const Unit& u, int wr, int wc, int fr, int fq) const {
        const int row0 = u.pm * 256 + wr * 64 + fr;
#pragma unroll
        for (int bj = 0; bj < 2; ++bj) {
            const int t0 = u.pn * 256 + bj * 128 + wc * 32 + 8 * fq, b = t0 / L, l = t0 - b * L;
            const f32x4 ra = *(const f32x4*)(rh + t0), rb = *(const f32x4*)(rh + t0 + 4);
#pragma unroll
            for (int ai = 0; ai < 2; ++ai)
#pragma unroll
                for (int m = 0; m < 4; ++m) {
                    const int np = row0 + ai * 128 + m * 16;
                    *(u32x4*)(XT + (size_t)(b * 256 + (np & 255)) * KD + (np >> 8) * LP + l) = pack8(acc[ai][bj][m][0] * ra, acc[ai][bj][m][1] * rb);
                }
        }
    }
};
struct EpiDFT {
    bf16_t* MIX; const bf16_t* U;
    __device__ __forceinline__ void operator()(AccRef acc, const Unit& u, int wr, int wc, int fr, int fq) const {
        const int row0 = u.pm * 256 + wr * 64 + fr, b = u.pn;
#pragma unroll
        for (int ai = 0; ai < 2; ++ai) {
            u32x4 gt[4][2];
#pragma unroll
            for (int m = 0; m < 4; ++m)
#pragma unroll
                for (int bj = 0; bj < 2; ++bj) gt[m][bj] = *(const u32x4*)(U + ((size_t)b * L + row0 + ai * 128 + m * 16) * UW + U_FG + bj * 128 + wc * 32 + 8 * fq);
#pragma unroll
            for (int m = 0; m < 4; ++m)
#pragma unroll
                for (int bj = 0; bj < 2; ++bj) { const size_t tok = (size_t)b * L + row0 + ai * 128 + m * 16; const int n = bj * 128 + wc * 32 + 8 * fq; const u32x4 g = gt[m][bj];
                    f32x4 v0 = acc[ai][bj][m][0], v1 = acc[ai][bj][m][1];
                    v0[0] *= bf_lo(g.x); v0[1] *= bf_hi(g.x); v0[2] *= bf_lo(g.y); v0[3] *= bf_hi(g.y);
                    v1[0] *= bf_lo(g.z); v1[1] *= bf_hi(g.z); v1[2] *= bf_lo(g.w); v1[3] *= bf_hi(g.w);
                    *(u32x4*)(MIX + tok * DM + n) = pack8(v0, v1); }
            __builtin_amdgcn_sched_barrier(0);
        }
    }
};
struct EpiQ {
    bf16_t* Q; const float* rq; const float* cs; const float* sn;
    __device__ __forceinline__ void operator()(AccRef acc, const Unit& u, int wr, int wc, int fr, int fq) const {
        const int row0 = u.pm * 256 + wr * 64 + fr;
        float rsv[2][4];
#pragma unroll
        for (int ai = 0; ai < 2; ++ai)
#pragma unroll
            for (int m = 0; m < 4; ++m) rsv[ai][m] = rq[row0 + ai * 128 + m * 16];
#pragma unroll
        for (int bj = 0; bj < 2; ++bj) {
            const int blk = u.pn * 256 + bj * 128 + wc * 32, col0 = blk + 8 * fq, w = blk % 192;
            const bool dorope = w >= 128;
#pragma unroll
            for (int ai = 0; ai < 2; ++ai)
#pragma unroll
                for (int m = 0; m < 4; ++m) {
                    const int row = row0 + ai * 128 + m * 16; const float rs = rsv[ai][m];
                    f32x4 v0 = acc[ai][bj][m][0] * rs, v1 = acc[ai][bj][m][1] * rs;
                    if (dorope) rope8(v0, v1, cs, sn, row % L, (w - 128 + 8 * fq) >> 3);
                    *(u32x4*)(Q + (size_t)row * QW + col0) = pack8(v0, v1);
                    if (m == 3) __builtin_amdgcn_sched_barrier(0);
                }
        }
    }
};
struct EpiKV {
    bf16_t* KV; const float* rkv;
    __device__ __forceinline__ void operator()(AccRef acc, const Unit& u, int wr, int wc, int fr, int fq) const {
        const int row0 = u.pm * 256 + wr * 64 + fr;
        float rsv[2][4];
#pragma unroll
        for (int ai = 0; ai < 2; ++ai)
#pragma unroll
            for (int m = 0; m < 4; ++m) rsv[ai][m] = rkv[row0 + ai * 128 + m * 16];
#pragma unroll
        for (int ai = 0; ai < 2; ++ai)
#pragma unroll
            for (int m = 0; m < 4; ++m) {
                const int row = row0 + ai * 128 + m * 16; const float rs = rsv[ai][m];
#pragma unroll
                for (int bj = 0; bj < 2; ++bj) {
                    const int col0 = u.pn * 256 + bj * 128 + wc * 32 + 8 * fq;
                    *(u32x4*)(KV + (size_t)row * KVW + col0) = pack8(acc[ai][bj][m][0] * rs, acc[ai][bj][m][1] * rs);
                }
            }
    }
};
struct EpiOut {
    bf16_t* H;
    __device__ __forceinline__ void operator()(AccRef acc, const Unit& u, int wr, int wc, int fr, int fq) const {
        const int row0 = u.pm * 256 + wr * 64 + fr;
#pragma unroll
        for (int ai = 0; ai < 2; ++ai) {
            u32x4 hv[4][2];
#pragma unroll
            for (int m = 0; m < 4; ++m)
#pragma unroll
                for (int bj = 0; bj < 2; ++bj) hv[m][bj] = *(const u32x4*)(H + (size_t)(row0 + ai * 128 + m * 16) * DM + u.pn * 256 + bj * 128 + wc * 32 + 8 * fq);
#pragma unroll
            for (int m = 0; m < 4; ++m)
#pragma unroll
                for (int bj = 0; bj < 2; ++bj) { const u32x4 g = hv[m][bj]; f32x4 v0 = acc[ai][bj][m][0], v1 = acc[ai][bj][m][1];
                    v0[0] += bf_lo(g.x); v0[1] += bf_hi(g.x); v0[2] += bf_lo(g.y); v0[3] += bf_hi(g.y);
                    v1[0] += bf_lo(g.z); v1[1] += bf_hi(g.z); v1[2] += bf_lo(g.w); v1[3] += bf_hi(g.w);
                    *(u32x4*)(H + (size_t)(row0 + ai * 128 + m * 16) * DM + u.pn * 256 + bj * 128 + wc * 32 + 8 * fq) = pack8(v0, v1); }
            __builtin_amdgcn_sched_barrier(0);
        }
    }
};
struct EpiAll {
    int kind; unsigned char* ws;
    __device__ __forceinline__ void operator()(AccRef acc, const Unit& u, int wr, int wc, int fr, int fq) const {
        asm volatile("" : "+v"(fr), "+v"(fq));
        bf16_t* U = (bf16_t*)(ws + WS_U); const float* COS = (const float*)(ws + WS_COS); const float* SIN = (const float*)(ws + WS_SIN);
        switch (kind) {
            case 0: { EpiU E{U, COS, SIN, (const float*)(ws + WS_RH)}; E(acc, u, wr, wc, fr, fq); break; }
            case 1: { EpiXT E{(bf16_t*)(ws + WS_XT), (const float*)(ws + WS_RH)}; E(acc, u, wr, wc, fr, fq); break; }
            case 2: { EpiDFT E{(bf16_t*)(ws + WS_HN), U}; E(acc, u, wr, wc, fr, fq); break; }
            case 3: { EpiQ E{(bf16_t*)(ws + WS_Q), (const float*)(ws + WS_RQ), COS, SIN}; E(acc, u, wr, wc, fr, fq); break; }
            case 4: { EpiKV E{(bf16_t*)(ws + WS_KV), (const float*)(ws + WS_RKV)}; E(acc, u, wr, wc, fr, fq); break; }
            default: { EpiOut E{(bf16_t*)(ws + WS_H)}; E(acc, u, wr, wc, fr, fq); break; }
        }
    }
};

namespace att {
constexpr int NW = 8, QBLK = 32, KVBLK = 64, NT = 65;
constexpr float SCALE = 0.07216878364870322f, THR = 8.f;
constexpr int SHM_V = 16384, SHM_K = 16384, SHM_R = 8192;
constexpr int OFF_V = 0, OFF_K = 2 * SHM_V, OFF_R = OFF_K + 2 * SHM_K, OFF_WS = OFF_R + 2 * SHM_R, OFF_QR = OFF_WS + 2048;
#define KSWZ(row, colB) ((row) * 256 + ((colB) ^ (((row) & 7) << 4)))
#define RSWZ(row, colB) ((row) * 128 + ((colB) ^ (((row) & 7) << 4)))
#define SBAR() __builtin_amdgcn_sched_barrier(0)
__device__ __forceinline__ int crow(int r, int hi) { return (r & 3) + 8 * (r >> 2) + 4 * hi; }
__device__ __forceinline__ void partialSM(f32x16& p0, f32x16& p1, float& m_reg, float& mn, float& alpha) {
    constexpr float C = SCALE * 1.4426950408889634f;
    float pmax = p0[0];
#pragma unroll
    for (int r = 1; r < 16; ++r) pmax = fmaxf(pmax, p0[r]);
#pragma unroll
    for (int r = 0; r < 16; ++r) pmax = fmaxf(pmax, p1[r]);
    { auto rr = __builtin_amdgcn_permlane32_swap(__float_as_uint(pmax), __float_as_uint(pmax), false, false);
      pmax = fmaxf(__uint_as_float(rr[0]), __uint_as_float(rr[1])); }
    if (__builtin_expect(__all(pmax - m_reg <= THR / SCALE), 1)) { mn = m_reg; alpha = 1.f; }
    else { mn = fmaxf(m_reg, pmax); alpha = __builtin_amdgcn_exp2f((m_reg - mn) * C); m_reg = mn; }
    const float mnC = -mn * C;
#pragma unroll
    for (int r = 0; r < 16; ++r) p0[r] = fmaf(p0[r], C, mnC);
#pragma unroll
    for (int r = 0; r < 16; ++r) p1[r] = fmaf(p1[r], C, mnC);
#pragma unroll
    for (int r = 0; r < 16; ++r) p0[r] = __builtin_amdgcn_exp2f(p0[r]);
}
__device__ __forceinline__ void finishSM(f32x16& p0, f32x16& p1, float alpha, float& l_reg, bf16x8& pa0, bf16x8& pa1, bf16x8& pa2, bf16x8& pa3) {
#pragma unroll
    for (int r = 0; r < 16; ++r) p1[r] = __builtin_amdgcn_exp2f(p1[r]);
    float ps = 0;
#pragma unroll
    for (int r = 0; r < 16; ++r) ps += p0[r];
#pragma unroll
    for (int r = 0; r < 16; ++r) ps += p1[r];
    { auto rr = __builtin_amdgcn_permlane32_swap(__float_as_uint(ps), __float_as_uint(ps), false, false);
      ps = __uint_as_float(rr[0]) + __uint_as_float(rr[1]); }
    l_reg = l_reg * alpha + ps;
#define PK4(P, BASE, OUT) do { unsigned a0 = cvt_pk_bf16(P[BASE + 0], P[BASE + 1]), a1 = cvt_pk_bf16(P[BASE + 2], P[BASE + 3]);   \
    unsigned b0 = cvt_pk_bf16(P[BASE + 4], P[BASE + 5]), b1 = cvt_pk_bf16(P[BASE + 6], P[BASE + 7]);                              \
    auto r0 = __builtin_amdgcn_permlane32_swap(a0, b0, false, false); auto r1 = __builtin_amdgcn_permlane32_swap(a1, b1, false, false); \
    u32x4 w = {r0[0], r1[0], r0[1], r1[1]}; OUT = *reinterpret_cast<bf16x8*>(&w); } while (0)
    PK4(p0, 0, pa0); PK4(p0, 8, pa1); PK4(p1, 0, pa2); PK4(p1, 8, pa3);
#undef PK4
}
__device__ __forceinline__ void qkt(f32x16& p0, f32x16& p1, const char* Ks, const char* Rs, const bf16x8* qr, const char* qrl, int r32, int hi) {
    p0 = f32x16{}; p1 = f32x16{};
#pragma unroll
    for (int d0 = 0; d0 < 8; ++d0) { const int cb = (d0 * 16 + hi * 8) * 2;
        bf16x8 b0 = *reinterpret_cast<const bf16x8*>(Ks + KSWZ(r32, cb));
        bf16x8 b1 = *reinterpret_cast<const bf16x8*>(Ks + KSWZ(32 + r32, cb));
        p0 = __builtin_amdgcn_mfma_f32_32x32x16_bf16(b0, qr[d0], p0, 0, 0, 0);
        p1 = __builtin_amdgcn_mfma_f32_32x32x16_bf16(b1, qr[d0], p1, 0, 0, 0); }
#pragma unroll
    for (int d0 = 0; d0 < 4; ++d0) { const int cb = (d0 * 16 + hi * 8) * 2;
        bf16x8 b0 = *reinterpret_cast<const bf16x8*>(Rs + RSWZ(r32, cb));
        bf16x8 b1 = *reinterpret_cast<const bf16x8*>(Rs + RSWZ(32 + r32, cb));
        const bf16x8 qv = *reinterpret_cast<const bf16x8*>(qrl + d0 * 1024);
        p0 = __builtin_amdgcn_mfma_f32_32x32x16_bf16(b0, qv, p0, 0, 0, 0);
        p1 = __builtin_amdgcn_mfma_f32_32x32x16_bf16(b1, qv, p1, 0, 0, 0); }
}
__device__ __forceinline__ void kmask(f32x16& p0, f32x16& p1, int k0, int hi) {
#pragma unroll
    for (int r = 0; r < 16; ++r) { const int kv = k0 + crow(r, hi); if (kv >= L) p0[r] = -1e30f; if (kv + 32 >= L) p1[r] = -1e30f; }
}
__device__ __forceinline__ int v_st(int k, int c) { const int kk = (k & ~0xC) | ((k & 4) << 1) | ((k & 8) >> 1); return ((kk >> 3) * 4 + (c >> 5)) * 512 + ((kk & 7) * 32 + (c & 31)) * 2; }
__device__ __forceinline__ int v_rd_base(int lane) { return ((lane & 3) << 3) | (((lane >> 2) & 3) << 6) | (((lane >> 4) & 1) << 5) | (((lane >> 5) & 1) << 8); }
constexpr int v_rd_off(int d0, int ks, int half) { return d0 * 512 + ks * 4096 + half * 2048; }
template <int OFF> __device__ __forceinline__ s16x4 tr_read(int vb) {
    s16x4 r; asm volatile("ds_read_b64_tr_b16 %0, %1 offset:%2" : "=&v"(r) : "v"(vb), "i"(OFF) : "memory"); return r;
}
template <int D0> __device__ __forceinline__ void pv_one(f32x16& od, int vb, bf16x8 pa0, bf16x8 pa1, bf16x8 pa2, bf16x8 pa3) {
    const s16x4 l0 = tr_read<v_rd_off(D0, 0, 0)>(vb), h0 = tr_read<v_rd_off(D0, 0, 1)>(vb), l1 = tr_read<v_rd_off(D0, 1, 0)>(vb), h1 = tr_read<v_rd_off(D0, 1, 1)>(vb);
    const s16x4 l2 = tr_read<v_rd_off(D0, 2, 0)>(vb), h2 = tr_read<v_rd_off(D0, 2, 1)>(vb), l3 = tr_read<v_rd_off(D0, 3, 0)>(vb), h3 = tr_read<v_rd_off(D0, 3, 1)>(vb);
    asm volatile("s_waitcnt lgkmcnt(0)" ::: "memory"); SBAR();
#define PK(Lx, Hx) (bf16x8){Lx[0], Lx[1], Lx[2], Lx[3], Hx[0], Hx[1], Hx[2], Hx[3]}
    od = __builtin_amdgcn_mfma_f32_32x32x16_bf16(pa0, PK(l0, h0), od, 0, 0, 0);
    od = __builtin_amdgcn_mfma_f32_32x32x16_bf16(pa1, PK(l1, h1), od, 0, 0, 0);
    od = __builtin_amdgcn_mfma_f32_32x32x16_bf16(pa2, PK(l2, h2), od, 0, 0, 0);
    od = __builtin_amdgcn_mfma_f32_32x32x16_bf16(pa3, PK(l3, h3), od, 0, 0, 0);
#undef PK
}
__device__ __forceinline__ void pv_d0(f32x16* o, int vb, bf16x8 pa0, bf16x8 pa1, bf16x8 pa2, bf16x8 pa3) {
    pv_one<0>(o[0], vb, pa0, pa1, pa2, pa3); pv_one<1>(o[1], vb, pa0, pa1, pa2, pa3); pv_one<2>(o[2], vb, pa0, pa1, pa2, pa3); pv_one<3>(o[3], vb, pa0, pa1, pa2, pa3);
}

__device__ __forceinline__ int swap23(int k) { return (k & ~0xC) | ((k & 4) << 1) | ((k & 8) >> 1); }
__device__ __forceinline__ void attn_unit(int b, int h, int qb, const bf16_t* __restrict__ Q, const bf16_t* __restrict__ KV, const bf16_t* __restrict__ U,
                                          bf16_t* __restrict__ MIX, char* lds, LAS unsigned char* ldsl, int t_begin, int t_end, float* __restrict__ part, int wave_s) {
    const int tid = opaque_tid_w(wave_s), wid = tid >> 6, lane = tid & 63, r32 = lane & 31, hi = lane >> 5;
    const int widu = __builtin_amdgcn_readfirstlane(wid);
    char* V_lds = lds + OFF_V; char* K_lds = lds + OFF_K; char* R_lds = lds + OFF_R;
    float* ws = (float*)(lds + OFF_WS) + wid * 64; float* li_l = ws; float* al_l = ws + 32;
    float m_reg = -1e30f, l_reg = 0; f32x16 o[4] = {}; bf16x8 qr[8];
    char* qrl = lds + OFF_QR + wid * 4096 + lane * 16;
    const size_t tok0 = (size_t)b * L;
    __syncthreads();
    { int qrow = qb * 256 + wid * QBLK + r32; if (qrow > L - 1) qrow = L - 1;
      const bf16_t* Qw = Q + (tok0 + qrow) * QW + h * 192 + hi * 8;
#pragma unroll
      for (int d0 = 0; d0 < 8; ++d0) qr[d0] = *(const bf16x8*)(Qw + d0 * 16);
#pragma unroll
      for (int d0 = 0; d0 < 4; ++d0) *(bf16x8*)(qrl + d0 * 1024) = *(const bf16x8*)(Qw + (8 + d0) * 16); }
    const char* Kh = (const char*)(KV + tok0 * KVW + h * 256); const char* Vh = Kh + 256; const char* Rh = (const char*)(U + tok0 * UW + U_KR);
    int rowK[2], colK[2], keyV[2], colV[2];
#pragma unroll
    for (int i = 0; i < 2; ++i) { const int pc = 2 * wid + i; rowK[i] = 4 * pc + (lane >> 4); colK[i] = ((lane & 15) ^ (rowK[i] & 7)) * 16;
        const int off = pc * 1024 + lane * 16, st = off >> 9; keyV[i] = swap23((st >> 2) * 8 + ((off & 511) >> 6)); colV[i] = ((st & 3) * 32 + ((off >> 4) & 3) * 8) * 2; }
    const int rowR = 8 * wid + (lane >> 3), colR = ((lane & 7) ^ (rowR & 7)) * 16;
    const int vb0 = (int)(uintptr_t)V_lds + v_rd_base(lane);
#define CLK(k) ((k) < L ? (k) : L - 1)
#define DMA_KR(bb, k0) do { _Pragma("unroll") for (int _i = 0; _i < 2; ++_i) \
        __builtin_amdgcn_global_load_lds((const unsigned*)(Kh + (unsigned)(CLK((k0) + rowK[_i]) * (KVW * 2) + colK[_i])), (LAS unsigned*)(ldsl + OFF_K + (bb) * SHM_K + (2 * widu + _i) * 1024), 16, 0, 0); \
        __builtin_amdgcn_global_load_lds((const unsigned*)(Rh + (unsigned)(CLK((k0) + rowR) * (UW * 2) + colR)), (LAS unsigned*)(ldsl + OFF_R + (bb) * SHM_R + widu * 1024), 16, 0, 0); } while (0)
#define DMA_V(bb, k0) do { _Pragma("unroll") for (int _i = 0; _i < 2; ++_i) \
        __builtin_amdgcn_global_load_lds((const unsigned*)(Vh + (unsigned)(CLK((k0) + keyV[_i]) * (KVW * 2) + colV[_i])), (LAS unsigned*)(ldsl + OFF_V + (bb) * SHM_V + (2 * widu + _i) * 1024), 16, 0, 0); } while (0)
#define WAITBAR() do { asm volatile("s_waitcnt vmcnt(0) lgkmcnt(0)" ::: "memory"); __builtin_amdgcn_s_barrier(); asm volatile("" ::: "memory"); } while (0)
    const int N = t_end - t_begin;
    DMA_KR(0, t_begin * KVBLK); DMA_V(0, t_begin * KVBLK); DMA_KR(1, (t_begin + 1) * KVBLK);
    WAITBAR();
    if (part && widu != 0) {
        WAITBAR();
#pragma unroll 1
        for (int j = 0; j < N; ++j) { const int bb = j & 1, jt = t_begin + j;
            if (j + 1 < N) DMA_V(bb ^ 1, (jt + 1) * KVBLK);
            if (j + 2 < N) DMA_KR(bb, (jt + 2) * KVBLK);
            WAITBAR(); }
        return;
    }
    f32x16 pn0, pn1;
    qkt(pn0, pn1, K_lds, R_lds, qr, qrl, r32, hi);
    WAITBAR();
#define ATT_BODY(MASKED) do { const int bb = j & 1, jt = t_begin + j; \
        if (j + 1 < N) DMA_V(bb ^ 1, (jt + 1) * KVBLK); \
        if (j + 2 < N) DMA_KR(bb, (jt + 2) * KVBLK); \
        f32x16 p0 = pn0, p1 = pn1; float mn, al; bf16x8 pa0, pa1, pa2, pa3; \
        if (MASKED) kmask(p0, p1, jt * KVBLK, hi); \
        qkt(pn0, pn1, K_lds + (bb ^ 1) * SHM_K, R_lds + (bb ^ 1) * SHM_R, qr, qrl, r32, hi);     \
        partialSM(p0, p1, m_reg, mn, al); \
        if (__any(al < 1.f)) { if (hi == 0) al_l[r32] = al; asm volatile("s_waitcnt lgkmcnt(0)" ::: "memory"); \
            _Pragma("unroll") for (int d = 0; d < 4; ++d) _Pragma("unroll") for (int r = 0; r < 16; ++r) o[d][r] *= al_l[crow(r, hi)]; } \
        finishSM(p0, p1, al, l_reg, pa0, pa1, pa2, pa3); SBAR(); \
        pv_d0(o, vb0 + bb * SHM_V, pa0, pa1, pa2, pa3); \
        WAITBAR(); } while (0)
    int j = 0;
#pragma unroll 1
    for (; j < N && (t_begin + j + 1) * KVBLK <= L; ++j) ATT_BODY(false);
#pragma unroll 1
    for (; j < N; ++j) ATT_BODY(true);
#undef ATT_BODY
    if (part) {
        if (wid == 0) {
#pragma unroll
            for (int r = 0; r < 16; ++r) { const int orow = crow(r, hi);
                if (orow < 16) {
#pragma unroll
                    for (int d0 = 0; d0 < 4; ++d0) part[orow * 128 + d0 * 32 + r32] = o[d0][r]; } }
            if (lane < 16) { part[2048 + lane] = m_reg; part[2064 + lane] = l_reg; }
        }
        return;
    }
    if (hi == 0) li_l[r32] = l_reg; asm volatile("s_waitcnt lgkmcnt(0)" ::: "memory");
    const int rbase = qb * 256 + wid * QBLK;
#pragma unroll
    for (int rh = 0; rh < 2; ++rh) {
        unsigned short gt[8][4];
#pragma unroll
        for (int r8 = 0; r8 < 8; ++r8) { const int r = rh * 8 + r8, prow = min(rbase + crow(r, hi), L - 1); const size_t t = tok0 + prow;
#pragma unroll
            for (int d0 = 0; d0 < 4; ++d0) gt[r8][d0] = U[t * UW + U_AG + h * 128 + d0 * 32 + r32]; }
#pragma unroll
        for (int r8 = 0; r8 < 8; ++r8) { const int r = rh * 8 + r8, orow = crow(r, hi), prow = rbase + orow;
            const float rli = __builtin_amdgcn_rcpf(li_l[orow]);
            if (prow < L) { const size_t t = tok0 + prow;
#pragma unroll
                for (int d0 = 0; d0 < 4; ++d0) { const int c = h * 128 + d0 * 32 + r32;
                    const float ov = o[d0][r] * rli * bf1(gt[r8][d0]); MIX[t * DM + 512 + c] = (bf16_t)(cvt_pk_bf16(ov, ov) & 0xffffu); } } }
    }
#undef DMA_KR
#undef DMA_V
#undef WAITBAR
#undef CLK
}
}

struct Args {
    const float* x; const float* meta; const float* norm_w; const float* w_in; const float* fourier_w; const float* pool_w; const float* pool_scale;
    const float* q_norm_w; const float* w_uq; const float* kv_norm_w; const float* w_ukv; const float* w_out; const float* final_norm_w;
    float* out; unsigned char* ws; int ph_lo, ph_hi;
};

__device__ __forceinline__ float wsrc(const Args& a, int layer, int mat, int k, int j) {
    const float* w_in = a.w_in + (size_t)layer * DM * DIN + (size_t)k * DIN;
    if (mat == 0) {
        const float nw = a.norm_w[layer * DM + k];
        if (j < 384) return w_in[1024 + j] * nw;
        if (j < 448) return w_in[1664 + rope_src(j - 384)] * nw;
        if (j < 512) return 0.f;
        if (j < 768) return w_in[1408 + j - 512] * nw;
        if (j < 1024) return w_in[256 + j - 768] * nw;
        if (j < 1280) return 0.f;
        if (j < 1536) return w_in[768 + j - 1280] * nw;
        return w_in[1728 + j - 1536] * nw;
    } else if (mat == 1) {
        return 0.f;
    } else if (mat == 2) {
        const int hh = j / 192, w = j % 192; const int col = w < 128 ? j : hh * 192 + 128 + rope_src(w - 128);
        return a.w_uq[((size_t)layer * 384 + k) * 768 + col] * a.q_norm_w[layer * 384 + k];
    } else if (mat == 3) {
        return a.w_ukv[((size_t)layer * 256 + k) * 1024 + j] * a.kv_norm_w[layer * 256 + k];
    }
    return a.w_out[((size_t)layer * 1024 + k) * 1024 + j];
}
__device__ __forceinline__ void prep_item(const Args& a, int layer, int mat, int K, bf16_t* WT, int item, int nblk, LAS float* scr, int lane) {
    const int kb = item / nblk, nb = item % nblk, k0 = 64 * kb, n0 = 32 * nb;
#pragma unroll 1
    for (int i0 = 0; i0 < 32; i0 += 8) { float tv[8];
#pragma unroll
        for (int e = 0; e < 8; ++e) tv[e] = wsrc(a, layer, mat, k0 + 2 * (i0 + e) + (lane >> 5), n0 + (lane & 31));
#pragma unroll
        for (int e = 0; e < 8; ++e) scr[(2 * (i0 + e) + (lane >> 5)) * 33 + (lane & 31)] = tv[e]; }
    asm volatile("s_waitcnt lgkmcnt(0)" ::: "memory");
    const int c = lane & 7;
#pragma unroll
    for (int jx = 0; jx < 4; ++jx) { const int n = (lane >> 3) + 8 * jx; const LAS float* s = scr + (8 * c) * 33 + n;
        u32x4 o; o.x = cvt_pk_bf16(s[0 * 33], s[1 * 33]); o.y = cvt_pk_bf16(s[2 * 33], s[3 * 33]); o.z = cvt_pk_bf16(s[4 * 33], s[5 * 33]); o.w = cvt_pk_bf16(s[6 * 33], s[7 * 33]);
        *(u32x4*)(WT + (size_t)(n0 + n) * K + k0 + 8 * c) = o; }
    asm volatile("s_waitcnt lgkmcnt(0)" ::: "memory");
}


__device__ __forceinline__ void fold_item(const float* __restrict__ w_in_l, const float* __restrict__ nw, const float* __restrict__ F, float fscale, int base, bf16_t* WT, int row0, int k0, int lane) {
    float Freg[64];
#pragma unroll
    for (int c = 0; c < 64; ++c) Freg[c] = F[c * 64 + lane] * fscale;
#pragma unroll 1
    for (int kk0 = 0; kk0 < 64; kk0 += 8) {
        float av[8], acc[8];
#pragma unroll
        for (int e = 0; e < 8; ++e) { av[e] = w_in_l[(size_t)(k0 + kk0 + e) * DIN + base + lane]; acc[e] = 0.f; }
#pragma unroll
        for (int c = 0; c < 64; ++c) { const float f = Freg[c];
#pragma unroll
            for (int e = 0; e < 8; ++e) acc[e] += __uint_as_float((unsigned)__builtin_amdgcn_readlane((int)__float_as_uint(av[e]), c)) * f; }
#pragma unroll
        for (int e = 0; e < 8; ++e) acc[e] *= nw[k0 + kk0 + e];
        u32x4 o; o.x = cvt_pk_bf16(acc[0], acc[1]); o.y = cvt_pk_bf16(acc[2], acc[3]); o.z = cvt_pk_bf16(acc[4], acc[5]); o.w = cvt_pk_bf16(acc[6], acc[7]);
        *(u32x4*)(WT + (size_t)(row0 + lane) * 1024 + k0 + kk0) = o;
    }
}


#define XB_TMO      128
#define XB_XCNT(j)  (256  + 64 * (j))
#define XB_XSUB(j)  (1280 + 64 * (j))
#define XB_XGEN(j)  (2304 + 64 * (j))
#define XB_TOP      3328
#define XB_TOPGEN   3392
#define XCD_BAR_WORDS 3456
#define XB_SPIN_CAP (1u << 18)
__device__ __forceinline__ unsigned xb_ld(unsigned* p)              { return __hip_atomic_load(p, __ATOMIC_RELAXED, __HIP_MEMORY_SCOPE_AGENT); }
__device__ __forceinline__ unsigned xb_add(unsigned* p, unsigned v) { return __hip_atomic_fetch_add(p, v, __ATOMIC_RELAXED, __HIP_MEMORY_SCOPE_AGENT); }
__device__ __forceinline__ unsigned xb_xcc_id() { return (unsigned)__builtin_amdgcn_s_getreg((3 << 11) | 20) & 0xFu; }
#define XB_SPIN(cond, bar) do { unsigned _sp = 0; while (cond) { __builtin_amdgcn_s_sleep(1); \
    if ((++_sp & 255u) == 0u) { if (xb_ld(&(bar)[XB_TMO])) break; if (_sp > XB_SPIN_CAP) { atomicAdd(&(bar)[XB_TMO], 1u); break; } } } } while (0)
__device__ __forceinline__ void xcd_barrier_complete(unsigned* bar, unsigned x, unsigned& nloc, unsigned& nx) {
    const unsigned G = gridDim.x;
    unsigned sum, cnt, mine, sp = 0u;
    for (;;) {
        sum = 0u; cnt = 0u; mine = 0u;
#pragma unroll
        for (unsigned j = 0; j < 16; ++j) { const unsigned c = xb_ld(&bar[XB_XCNT(j)]); sum += c; cnt += (c > 0u) ? 1u : 0u; mine = (j == x) ? c : mine; }
        if (sum == G) break;
        __builtin_amdgcn_s_sleep(1);
        if ((++sp & 255u) == 0u) { if (xb_ld(&bar[XB_TMO])) break; if (sp > XB_SPIN_CAP) { atomicAdd(&bar[XB_TMO], 1u); break; } }
    }
    nloc = mine > 0u ? mine : 1u; nx = cnt > 0u ? cnt : 1u;
}
__device__ __forceinline__ void xcd_barrier(unsigned* bar, volatile LAS unsigned* st, bool leader) {
    asm volatile("s_waitcnt vmcnt(0)" ::: "memory");
    __syncthreads();
    if (leader) {
        const unsigned x = xb_xcc_id();
        __builtin_amdgcn_s_waitcnt(0);
        unsigned nloc = st[0], nx = st[1];
        if (nloc == 0u) { xcd_barrier_complete(bar, x, nloc, nx); st[0] = nloc; st[1] = nx; }
        const unsigned old = xb_add(&bar[XB_XSUB(x)], 1u);
        const unsigned gen = old / nloc;
        if (old + 1u == (gen + 1u) * nloc) {
            __builtin_amdgcn_fence(__ATOMIC_RELEASE, "agent");
            asm volatile("s_waitcnt vmcnt(0)" ::: "memory");
            const unsigned og = xb_add(&bar[XB_TOP], 1u);
            const unsigned tg = og / nx;
            if (og + 1u == (tg + 1u) * nx) xb_add(&bar[XB_TOPGEN], 1u);
            else XB_SPIN(xb_ld(&bar[XB_TOPGEN]) == tg, bar);
            __builtin_amdgcn_fence(__ATOMIC_ACQUIRE, "agent");
            xb_add(&bar[XB_XGEN(x)], 1u);
            asm volatile("s_waitcnt vmcnt(0)" ::: "memory");
        } else {
            XB_SPIN(xb_ld(&bar[XB_XGEN(x)]) == gen, bar);
            __builtin_amdgcn_fence(__ATOMIC_ACQUIRE, "agent");
            asm volatile("s_waitcnt vmcnt(0)" ::: "memory");
        }
    }
    __syncthreads();
}

#ifndef PHMASK
#define PHMASK 0xFF
#endif
#define PHM(k) ((PHMASK >> (k)) & 1)
#ifndef Q3
#define Q3 15
#endif
__global__ void __launch_bounds__(512) hymba_fwd(Args a) {
    extern __shared__ __attribute__((aligned(16))) unsigned char lds[];
    cg::grid_group grid = cg::this_grid();
    const int wave_s = __builtin_amdgcn_readfirstlane((int)threadIdx.x >> 6);
    if (threadIdx.x == 0) { volatile LAS unsigned* xst0 = (volatile LAS unsigned*)((LAS unsigned char*)lds + 135168); xst0[0] = 0u; xst0[1] = 0u;
        (void)xb_add(&((unsigned*)(a.ws + WS_BAR))[XB_XCNT(xb_xcc_id())], 1u); }
    __syncthreads();
#pragma unroll 1
    for (int ph = a.ph_lo; ph < a.ph_hi; ++ph) {
    size_t wz = 0; asm volatile("" : "+s"(wz));
    unsigned char* ws = a.ws + wz;
    const int tid = opaque_tid_w(wave_s), lane = tid & 63, wave = __builtin_amdgcn_readfirstlane(tid >> 6);
    int G = gridDim.x, bx = blockIdx.x; asm volatile("" : "+s"(G), "+s"(bx));
    const int vcu = (G % 8 == 0) ? (bx % 8) * (G / 8) + bx / 8 : bx;
    const int gw = vcu * 8 + wave, NGW = G * 8;
    bf16_t* H = (bf16_t*)(ws + WS_H); float* RH = (float*)(ws + WS_RH); bf16_t* MIX = (bf16_t*)(ws + WS_HN); bf16_t* U = (bf16_t*)(ws + WS_U);
    bf16_t* XT = (bf16_t*)(ws + WS_XT); bf16_t* DFT = (bf16_t*)(ws + WS_DFT); bf16_t* Qb = (bf16_t*)(ws + WS_Q); bf16_t* KVb = (bf16_t*)(ws + WS_KV);
    bf16_t* WN = (bf16_t*)(ws + WS_WN); bf16_t* WF = (bf16_t*)(ws + WS_WF); bf16_t* WQ = (bf16_t*)(ws + WS_WQ); bf16_t* WKV = (bf16_t*)(ws + WS_WKV); bf16_t* WO = (bf16_t*)(ws + WS_WO);
    float* RQ = (float*)(ws + WS_RQ); float* RKV = (float*)(ws + WS_RKV); float* COS = (float*)(ws + WS_COS); float* SIN = (float*)(ws + WS_SIN);
    float* CWF = (float*)(ws + WS_CWF); float* SWF = (float*)(ws + WS_SWF);
    LAS unsigned char* ldsl = (LAS unsigned char*)lds;
    {
        if (ph == 0 && PHM(6)) {
            float* tabc = (float*)lds; float* tabs = tabc + L;
            for (int m = tid; m < L; m += 512) { float s, c; sincospif(2.0f * (float)m / (float)L, &s, &c); tabc[m] = c; tabs[m] = s; }
            __syncthreads();
            for (int k = bx; k < L; k += G) {
                bf16_t* row = DFT + (size_t)k * KF;
                for (int ch = tid; ch < KF / 8; ch += 512) {
                    const int c0 = ch * 8, hs = c0 >= LF, l0 = c0 - hs * LF;
                    int idx = (int)(((long)k * l0) % L); float v[8];
#pragma unroll
                    for (int e = 0; e < 8; ++e) { const bool ok = (l0 + e) <= LH; v[e] = ok ? (hs ? -tabs[idx] : tabc[idx]) : 0.f; idx += k; if (idx >= L) idx -= L; }
                    u32x4 o; o.x = cvt_pk_bf16(v[0], v[1]); o.y = cvt_pk_bf16(v[2], v[3]); o.z = cvt_pk_bf16(v[4], v[5]); o.w = cvt_pk_bf16(v[6], v[7]);
                    *(u32x4*)(row + c0) = o;
                }
            }
            for (int i = bx * 512 + tid; i < L * 32; i += G * 512) { const int pos = i >> 5, ii = i & 31;
                const float inv = 1.0f / powf(10000.0f, (float)(2 * ii) / 64.0f); const float ang = (float)pos * inv; float s, c; sincosf(ang, &s, &c); COS[i] = c; SIN[i] = s; }
            for (int i = bx * 512 + tid; i < DEPTH * 4 * 64 * 64; i += G * 512) { const int d = i & 63, c = (i >> 6) & 63, lh = i >> 12;
                const float* Wf = a.fourier_w + (size_t)lh * 4096 + d; float sc_ = 0.f, ss_ = 0.f;
                for (int e = 0; e < 64; ++e) { float s, cc; sincospif((float)((c * e) & 63) / 32.0f, &s, &cc); const float w = Wf[e * 64]; sc_ += cc * w; ss_ += s * w; }
                const float nrm = rsqrtf((float)L * 64.0f); CWF[i] = sc_ * nrm; SWF[i] = ss_ * nrm; }
            for (int i = bx * 512 + tid; i < 4096 * 2 * 14; i += G * 512) { const int ch = i % 14, hs = (i / 14) & 1, r = i / 28;
                const unsigned z = __float_as_uint(opaque_zero()); *(u32x4*)(XT + (size_t)r * KD + hs * LP + L + ch * 8) = (u32x4){z, z, z, z}; }
            __syncthreads();
        } else if (ph == 1 + 6 * DEPTH && PHM(7)) {
            for (int r = gw; r < NB * SEQ; r += NGW) { const int b = r >> 12, s = r & 4095;
                const u32x4* xr = (const u32x4*)(H + ((size_t)b * L + NMETA + s) * DM) + lane; const u32x4 x0 = xr[0], x1 = xr[64];
                float v[16]; v[0] = bf_lo(x0.x); v[1] = bf_hi(x0.x); v[2] = bf_lo(x0.y); v[3] = bf_hi(x0.y); v[4] = bf_lo(x0.z); v[5] = bf_hi(x0.z); v[6] = bf_lo(x0.w); v[7] = bf_hi(x0.w);
                v[8] = bf_lo(x1.x); v[9] = bf_hi(x1.x); v[10] = bf_lo(x1.y); v[11] = bf_hi(x1.y); v[12] = bf_lo(x1.z); v[13] = bf_hi(x1.z); v[14] = bf_lo(x1.w); v[15] = bf_hi(x1.w);
                float ss = 0.f;
#pragma unroll
                for (int e = 0; e < 16; ++e) ss += v[e] * v[e];
                const float rstd = rsqrtf(wave_sum(ss) * (1.f / DM) + NORM_EPS);
                float* orow = a.out + (size_t)r * DM; const float* fw = a.final_norm_w;
#pragma unroll
                for (int hlf = 0; hlf < 2; ++hlf) { const int c0 = hlf * 512 + lane * 8; const f32x4 w0 = *(const f32x4*)(fw + c0), w1 = *(const f32x4*)(fw + c0 + 4);
                    f32x4 o0 = {v[hlf * 8 + 0] * rstd * w0[0], v[hlf * 8 + 1] * rstd * w0[1], v[hlf * 8 + 2] * rstd * w0[2], v[hlf * 8 + 3] * rstd * w0[3]};
                    f32x4 o1 = {v[hlf * 8 + 4] * rstd * w1[0], v[hlf * 8 + 5] * rstd * w1[1], v[hlf * 8 + 6] * rstd * w1[2], v[hlf * 8 + 7] * rstd * w1[3]};
                    *(f32x4*)(orow + c0) = o0; *(f32x4*)(orow + c0 + 4) = o1; } }
        } else if (ph > 0 && ph < 1 + 6 * DEPTH) {
            const int layer = (ph - 1) / 6, kind = (ph - 1) % 6;
            if (kind == 0 && PHM(0)) {
                LAS float* scr = (LAS float*)(ldsl + wave * 8448);
                constexpr int I0 = 16 * 64, IF = 192, I2 = 6 * 24, I3 = 4 * 32, I4 = 16 * 32;
                for (int it = gw; it < IF + I0 + I2 + I3 + I4; it += NGW) { int r = it;
                    if (r < IF) {
                        const float* w_in_l = a.w_in + (size_t)layer * DM * DIN; const float* nw = a.norm_w + layer * DM; const int kb = r & 15, part = r >> 4;
                        if (part < 4) fold_item(w_in_l, nw, a.pool_w + (size_t)(layer * 4 + part) * 4096, a.pool_scale[layer * 256 + part * 64 + lane], 512 + part * 64, WN, 1024 + part * 64, kb * 64, lane);
                        else { const int pp = part - 4, hh = pp & 3, sn = pp >> 2;
                            fold_item(w_in_l, nw, (sn ? SWF : CWF) + (size_t)(layer * 4 + hh) * 4096, 1.f, hh * 64, WF, sn * 256 + hh * 64, kb * 64, lane); }
                        continue; } r -= IF;
                    if (r < I0) { if ((r & 63) < 32 || (r & 63) >= 40) prep_item(a, layer, 0, 1024, WN, r, 64, scr, lane); continue; } r -= I0;
                    if (r < I2) { prep_item(a, layer, 2, 384, WQ, r, 24, scr, lane); continue; } r -= I2;
                    if (r < I3) { prep_item(a, layer, 3, 256, WKV, r, 32, scr, lane); continue; } r -= I3;
                    prep_item(a, layer, 4, 1024, WO, r, 32, scr, lane); }
                if (layer == 0) {
                    for (int r0 = gw * 4; r0 < MTOK; r0 += NGW * 4) {
                        f32x4 v[4][4]; float ss[4];
#pragma unroll
                        for (int q = 0; q < 4; ++q) { const int r = r0 + q; const int b = r / L, l = r - b * L;
                            const float* src = l < NMETA ? a.meta + (size_t)l * DM : a.x + ((size_t)b * SEQ + l - NMETA) * DM;
                            const f32x4* xr = (const f32x4*)src + lane;
#pragma unroll
                            for (int j = 0; j < 4; ++j) v[q][j] = xr[64 * j]; }
#pragma unroll
                        for (int q = 0; q < 4; ++q) { float t = 0.f;
#pragma unroll
                            for (int j = 0; j < 4; ++j) t += v[q][j].x * v[q][j].x + v[q][j].y * v[q][j].y + v[q][j].z * v[q][j].z + v[q][j].w * v[q][j].w;
                            ss[q] = t; }
#pragma unroll
                        for (int o = 1; o < 64; o <<= 1) {
#pragma unroll
                            for (int q = 0; q < 4; ++q) ss[q] += __uint_as_float((unsigned)__builtin_amdgcn_ds_bpermute((lane ^ o) << 2, (int)__float_as_uint(ss[q]))); }
#pragma unroll
                        for (int q = 0; q < 4; ++q) { const int r = r0 + q;
                            if (lane == 0) RH[r] = rsqrtf(ss[q] * (1.f / DM) + NORM_EPS);
                            u32x2* o8 = (u32x2*)(H + (size_t)r * DM) + lane;
#pragma unroll
                            for (int j = 0; j < 4; ++j) { u32x2 w; w.x = cvt_pk_bf16(v[q][j].x, v[q][j].y); w.y = cvt_pk_bf16(v[q][j].z, v[q][j].w); o8[64 * j] = w; } }
                    }
                } else {
                    for (int r0 = gw * 8; r0 < MTOK; r0 += NGW * 8) {
                        u32x4 v[8][2]; float ss[8];
#pragma unroll
                        for (int q = 0; q < 8; ++q) { const u32x4* xr = (const u32x4*)(H + (size_t)(r0 + q) * DM) + lane; v[q][0] = xr[0]; v[q][1] = xr[64]; }
#pragma unroll
                        for (int q = 0; q < 8; ++q) { float t = 0.f;
#pragma unroll
                            for (int j = 0; j < 2; ++j) { const u32x4 x = v[q][j]; float e;
                                e = bf_lo(x.x); t += e * e; e = bf_hi(x.x); t += e * e; e = bf_lo(x.y); t += e * e; e = bf_hi(x.y); t += e * e;
                                e = bf_lo(x.z); t += e * e; e = bf_hi(x.z); t += e * e; e = bf_lo(x.w); t += e * e; e = bf_hi(x.w); t += e * e; }
                            ss[q] = t; }
#pragma unroll
                        for (int o = 1; o < 64; o <<= 1) {
#pragma unroll
                            for (int q = 0; q < 8; ++q) ss[q] += __uint_as_float((unsigned)__builtin_amdgcn_ds_bpermute((lane ^ o) << 2, (int)__float_as_uint(ss[q]))); }
                        if (lane < 8) { float sv = ss[0];
#pragma unroll
                            for (int q = 1; q < 8; ++q) sv = (lane == q) ? ss[q] : sv;
                            RH[r0 + lane] = rsqrtf(sv * (1.f / DM) + NORM_EPS); }
                    }
                }
            } else if ((kind == 1 || kind == 3 || kind == 5) && PHM(1)) {
                const int j0 = kind == 1 ? 0 : (kind == 3 ? 2 : 5), j1 = kind == 1 ? 2 : (kind == 3 ? 5 : 6);
                if (kind == 5) {
                    const float* PART = (const float*)(ws + WS_PART);
                    for (int gi = bx * 512 + tid; gi < 64 * 16 * 128; gi += G * 512) { const int col = gi & 127, row = (gi >> 7) & 15, bh = gi >> 11; constexpr float C = att::SCALE * 1.4426950408889634f;
                        const float* p0 = PART + (size_t)(bh * 4) * PART_STRIDE; float m = -1e30f;
#pragma unroll
                        for (int q = 0; q < 4; ++q) m = fmaxf(m, p0[q * PART_STRIDE + 2048 + row]);
                        float lsum = 0.f, osum = 0.f;
#pragma unroll
                        for (int q = 0; q < 4; ++q) { const float w = __builtin_amdgcn_exp2f((p0[q * PART_STRIDE + 2048 + row] - m) * C); lsum += p0[q * PART_STRIDE + 2064 + row] * w; osum += p0[q * PART_STRIDE + row * 128 + col] * w; }
                        const size_t t = (size_t)(bh >> 2) * L + 4096 + row; const int c = (bh & 3) * 128 + col;
                        const float ov = osum / lsum * bf1(U[t * UW + U_AG + c]); MIX[t * DM + 512 + c] = (bf16_t)(cvt_pk_bf16(ov, ov) & 0xffffu); }
                    asm volatile("s_waitcnt vmcnt(0) lgkmcnt(0)" ::: "memory");
                    xcd_barrier((unsigned*)(ws + WS_BAR), (volatile LAS unsigned*)(ldsl + 135168), tid == 0);
                }
#pragma unroll 1
                for (int jb = j0; jb < j1; ++jb) {
                    pg8::Gemm g;
                    if (jb == 0)      g = pg8::Gemm{H, WN, MTOK, UW, DM, DM, DM};
                    else if (jb == 1) g = pg8::Gemm{WF, H, 512, MTOK, DM, DM, DM};
                    else if (jb == 2) g = pg8::Gemm{DFT, XT, 4096, 4096, KF, KF, KD};
                    else if (jb == 3) g = pg8::Gemm{U + U_CQ, WQ, MTOK, QW, 384, UW, 384};
                    else if (jb == 4) g = pg8::Gemm{U + U_CKV, WKV, MTOK, KVW, 256, UW, 256};
                    else              g = pg8::Gemm{MIX, WO, MTOK, DM, DM, DM, DM};
                    const int rot = (jb == 1 || jb == 4) ? 8 : (jb == 3 ? 16 : 0);
                    pg8::StaticOrder S; S.init(g.M, g.N, G, (bx + G - rot) % G); EpiAll E{jb, ws};
                    pg8::gemm_phase<EpiAll>(ldsl, g, S, E, wave_s);
                    if (jb == 2) {
                for (int it = vcu; it < 256; it += G) {
                    const int fr = lane & 15, fq = lane >> 4;
                    const bf16_t* ap = DFT + (size_t)(4096 + fr) * KF + wave * 544 + fq * 8;
                    const bf16_t* bp = XT + (size_t)(it * 16 + fr) * KD + wave * 544 + fq * 8;
                    const float z0 = opaque_zero(); f32x4 c = {z0, z0, z0, z0};
#pragma unroll
                    for (int s0 = 0; s0 < 18; s0 += 6) { bf16x8 av[6], bv[6];
#pragma unroll
                        for (int e = 0; e < 6; ++e) if (s0 + e < 17) { av[e] = *(const bf16x8*)(ap + (s0 + e) * 32); bv[e] = *(const bf16x8*)(bp + (s0 + e) * 32); }
#pragma unroll
                        for (int e = 0; e < 6; ++e) if (s0 + e < 17) c = __builtin_amdgcn_mfma_f32_16x16x32_bf16(av[e], bv[e], c, 0, 0, 0); }
                    float* red = (float*)lds;
                    __syncthreads();
#pragma unroll
                    for (int j = 0; j < 4; ++j) red[wave * 256 + (fq * 4 + j) * 16 + fr] = c[j];
                    __syncthreads();
                    if (tid < 256) { float s = 0.f;
#pragma unroll
                        for (int w = 0; w < 8; ++w) s += red[w * 256 + tid];
                        const int kr = tid >> 4, cc = it * 16 + (tid & 15), b = cc >> 8, n = cc & 255; const size_t tok = (size_t)b * L + 4096 + kr;
                        const float gt = bf1(U[tok * UW + U_FG + n]);
                        { const float sv = s * gt; MIX[tok * DM + n] = (bf16_t)(cvt_pk_bf16(sv, sv) & 0xffffu); } }
                    __syncthreads();
                }
                    }
                }
            } else if (kind == 2 && PHM(2)) {
                for (int pr = gw; pr < MTOK / 2; pr += NGW) {
                    const int t0 = pr * 2;
#pragma unroll
                    for (int q = 0; q < 2; ++q) { const bf16_t* row = U + (size_t)(t0 + q) * UW;
                        const u32x4 x = *(const u32x4*)(row + lane * 8); float sq = 0.f, sk = 0.f;
                        if (lane < 48) { float e; e = bf_lo(x.x); sq += e * e; e = bf_hi(x.x); sq += e * e; e = bf_lo(x.y); sq += e * e; e = bf_hi(x.y); sq += e * e;
                                         e = bf_lo(x.z); sq += e * e; e = bf_hi(x.z); sq += e * e; e = bf_lo(x.w); sq += e * e; e = bf_hi(x.w); sq += e * e; }
                        if (lane < 32) { const u32x4 y = *(const u32x4*)(row + U_CKV + lane * 8); float e;
                                         e = bf_lo(y.x); sk += e * e; e = bf_hi(y.x); sk += e * e; e = bf_lo(y.y); sk += e * e; e = bf_hi(y.y); sk += e * e;
                                         e = bf_lo(y.z); sk += e * e; e = bf_hi(y.z); sk += e * e; e = bf_lo(y.w); sk += e * e; e = bf_hi(y.w); sk += e * e; }
                        sq = wave_sum(sq); sk = wave_sum(sk);
                        if (lane == 0) { RQ[t0 + q] = rsqrtf(sq * (1.f / 384.f) + NORM_EPS); RKV[t0 + q] = rsqrtf(sk * (1.f / 256.f) + NORM_EPS); } }
                    const int t = t0 + (lane >> 5), cgp = lane & 31, b = t / L, l = t - b * L, gI = cgp >> 3, half = 1 << gI;
                    const int lo = max(l - half, 0), hi = min(l + half, L);
                    float s[8] = {0.f, 0.f, 0.f, 0.f, 0.f, 0.f, 0.f, 0.f};
                    const bf16_t* base = U + (size_t)b * L * UW + U_PP + cgp * 8;
                    u32x4 xw[16];
#pragma unroll
                    for (int i = 0; i < 16; ++i) { int tt = l - 8 + i; tt = tt < 0 ? 0 : (tt > L - 1 ? L - 1 : tt); xw[i] = *(const u32x4*)(base + (size_t)tt * UW); }
#pragma unroll
                    for (int i = 0; i < 16; ++i) { const int tt = l - 8 + i; const float wgt = (tt >= lo && tt < hi) ? 1.f : 0.f; const u32x4 x = xw[i];
                        s[0] += wgt * bf_lo(x.x); s[1] += wgt * bf_hi(x.x); s[2] += wgt * bf_lo(x.y); s[3] += wgt * bf_hi(x.y); s[4] += wgt * bf_lo(x.z); s[5] += wgt * bf_hi(x.z); s[6] += wgt * bf_lo(x.w); s[7] += wgt * bf_hi(x.w); }
                    const float ic = 1.f / (float)(hi - lo);
                    const u32x4 xs = *(const u32x4*)(base + (size_t)l * UW); const u32x4 gt = *(const u32x4*)(U + (size_t)t * UW + U_PG + cgp * 8);
                    float y[8];
                    y[0] = (s[0] * ic - bf_lo(xs.x)) * bf_lo(gt.x); y[1] = (s[1] * ic - bf_hi(xs.x)) * bf_hi(gt.x);
                    y[2] = (s[2] * ic - bf_lo(xs.y)) * bf_lo(gt.y); y[3] = (s[3] * ic - bf_hi(xs.y)) * bf_hi(gt.y);
                    y[4] = (s[4] * ic - bf_lo(xs.z)) * bf_lo(gt.z); y[5] = (s[5] * ic - bf_hi(xs.z)) * bf_hi(gt.z);
                    y[6] = (s[6] * ic - bf_lo(xs.w)) * bf_lo(gt.w); y[7] = (s[7] * ic - bf_hi(xs.w)) * bf_hi(gt.w);
                    u32x4 o; o.x = cvt_pk_bf16(y[0], y[1]); o.y = cvt_pk_bf16(y[2], y[3]); o.z = cvt_pk_bf16(y[4], y[5]); o.w = cvt_pk_bf16(y[6], y[7]);
                    *(u32x4*)(MIX + (size_t)t * DM + 256 + cgp * 8) = o;
                }
                { bf16_t* rowl = (bf16_t*)(lds + wave * 16896);
                  for (int r = gw; r < 4096; r += NGW) { bf16_t* xr = XT + (size_t)r * KD;
                      { u32x4 tmpv[17];
#pragma unroll
                        for (int it = 0; it < 17; ++it) { const int c = lane + 64 * it; if (c < KD / 8) tmpv[it] = *(const u32x4*)(xr + c * 8); }
#pragma unroll
                        for (int it = 0; it < 17; ++it) { const int c = lane + 64 * it; if (c < KD / 8) *(u32x4*)(rowl + c * 8) = tmpv[it]; } }
                      asm volatile("s_waitcnt vmcnt(0) lgkmcnt(0)" ::: "memory");
                      for (int c = lane; c < KF / 8; c += 64) { const int c0 = c * 8, hs = c0 >= LF, l0 = c0 - hs * LF; const bf16_t* hb = rowl + hs * LP; float v[8];
#pragma unroll
                          for (int e = 0; e < 8; ++e) { const int l = l0 + e; float x = 0.f;
                              if (l <= LH) { x = bf1(hb[l]); if (l > 0 && l < LH) { const float y = bf1(hb[L - l]); x = hs ? x - y : x + y; } else if (hs) x = 0.f; }
                              v[e] = x; }
                          u32x4 o; o.x = cvt_pk_bf16(v[0], v[1]); o.y = cvt_pk_bf16(v[2], v[3]); o.z = cvt_pk_bf16(v[4], v[5]); o.w = cvt_pk_bf16(v[6], v[7]);
                          *(u32x4*)(xr + c0) = o; }
                      asm volatile("s_waitcnt vmcnt(0) lgkmcnt(0)" ::: "memory"); } }
            } else if (kind == 4 && PHM(4)) {
                float* PART = (float*)(ws + WS_PART);
                for (int i = 0;; ++i) { const int uidx = i * G + vcu; if (uidx >= 1024 + 256) break;
                    if (uidx < 1024) { const int bh = uidx >> 4, qb = uidx & 15; att::attn_unit(bh >> 2, bh & 3, qb, Qb, KVb, U, MIX, (char*)lds, ldsl, 0, att::NT, nullptr, wave_s); }
                    else { const int v = uidx - 1024, bh = v >> 2, q = v & 3;
                        const int tb = q < 2 ? 17 * q : 34 + 16 * (q - 2), te = q < 2 ? tb + 17 : (q == 2 ? tb + 16 : att::NT);
                        att::attn_unit(bh >> 2, bh & 3, 16, Qb, KVb, U, MIX, (char*)lds, ldsl, tb, te, PART + (size_t)v * PART_STRIDE, wave_s); } }
                __syncthreads();
            }
        }
    }
        asm volatile("s_waitcnt vmcnt(0) lgkmcnt(0)" ::: "memory");
        if (ph + 1 < a.ph_hi) {
            if (ph == a.ph_lo) grid.sync();
            else xcd_barrier((unsigned*)(ws + WS_BAR), (volatile LAS unsigned*)(ldsl + 135168), tid == 0);
        }
    }
}


#ifndef N_LAUNCH_SPLIT
#define N_LAUNCH_SPLIT 0
#endif
extern "C" void kernel_launch(void* const* d_in, const int* in_sizes, int n_in, void* d_out, int out_size, void* d_ws, size_t ws_size, hipStream_t stream) {
    static int grid = 0;
    if (grid == 0) {
        if (n_in != 13 || in_sizes[0] != NB * SEQ * DM || out_size != NB * SEQ * DM || ws_size < WS_END + 256) {
            fprintf(stderr, "kernel_launch: shape/workspace mismatch: n_in %d in0 %d out %d ws %zu (need %zu)\n", n_in, n_in > 0 ? in_sizes[0] : -1, out_size, ws_size, (size_t)WS_END); grid = -1; return; }
        int dev = 0, cus = 0, per_cu = 0;
        hipGetDevice(&dev); hipDeviceGetAttribute(&cus, hipDeviceAttributeMultiprocessorCount, dev);
        if (hipFuncSetAttribute((const void*)hymba_fwd, hipFuncAttributeMaxDynamicSharedMemorySize, LDS_BYTES) != hipSuccess) { fprintf(stderr, "kernel_launch: hipFuncSetAttribute failed\n"); grid = -1; return; }
        if (hipOccupancyMaxActiveBlocksPerMultiprocessor(&per_cu, (const void*)hymba_fwd, 512, LDS_BYTES) != hipSuccess || per_cu < 1) { fprintf(stderr, "kernel_launch: occupancy query gave %d\n", per_cu); per_cu = 1; }
        (void)hipGetLastError();
        grid = cus;
    }
    if (grid < 0) return;
    Args a{};
    a.x = (const float*)d_in[0]; a.meta = (const float*)d_in[1]; a.norm_w = (const float*)d_in[2]; a.w_in = (const float*)d_in[3]; a.fourier_w = (const float*)d_in[4];
    a.pool_w = (const float*)d_in[5]; a.pool_scale = (const float*)d_in[6]; a.q_norm_w = (const float*)d_in[7]; a.w_uq = (const float*)d_in[8]; a.kv_norm_w = (const float*)d_in[9];
    a.w_ukv = (const float*)d_in[10]; a.w_out = (const float*)d_in[11]; a.final_norm_w = (const float*)d_in[12];
    a.out = (float*)d_out; a.ws = (unsigned char*)d_ws;
    constexpr int NPH = 2 + 6 * DEPTH;
#if N_LAUNCH_SPLIT
    for (int p = 0; p < NPH; ++p) { a.ph_lo = p; a.ph_hi = p + 1; void* args[] = {&a};
        hipError_t e = hipLaunchCooperativeKernel((void*)hymba_fwd, dim3(grid), dim3(512), args, LDS_BYTES, stream);
        if (e != hipSuccess) { fprintf(stderr, "cooperative launch failed: %s\n", hipGetErrorString(e)); break; } }
#else
    (void)hipMemsetAsync((char*)d_ws + WS_BAR, 0, (size_t)XCD_BAR_WORDS * 4, stream);
    a.ph_lo = 0; a.ph_hi = NPH; void* args[] = {&a};
    hipError_t e = hipLaunchCooperativeKernel((void*)hymba_fwd, dim3(grid), dim3(512), args, LDS_BYTES, stream);
    if (e != hipSuccess) fprintf(stderr, "cooperative launch failed: %s (grid %d)\n", hipGetErrorString(e), grid);
#endif
}
```

```cpp
#include <hip/hip_runtime.h>
#include <hip/hip_cooperative_groups.h>
#include <cstdio>
#include <cstdint>
namespace cg = cooperative_groups;

#define LAS __attribute__((address_space(3)))
typedef unsigned short bf16_t;
typedef short bf16x8 __attribute__((ext_vector_type(8)));
typedef short s16x4 __attribute__((ext_vector_type(4)));
typedef float f32x4 __attribute__((ext_vector_type(4)));
typedef float f32x8 __attribute__((ext_vector_type(8)));
typedef float f32x16 __attribute__((ext_vector_type(16)));
typedef unsigned u32x4 __attribute__((ext_vector_type(4)));
typedef unsigned u32x2 __attribute__((ext_vector_type(2)));

constexpr int DM = 1024, NB = 16, SEQ = 4096, NMETA = 16, L = SEQ + NMETA, MTOK = NB * L, DEPTH = 4;
constexpr int DIN = 2240, UW = 2048;
constexpr int LP = 4224, KD = 2 * LP;
constexpr int LH = L / 2, LF = 2176, KF = 2 * LF;
constexpr int QW = 768, KVW = 1024;
constexpr float NORM_EPS = 1e-6f;
constexpr int U_CQ = 0, U_KR = 384, U_CKV = 512, U_FG = 768, U_PP = 1024, U_PG = 1280, U_AG = 1536;

constexpr size_t al256(size_t x) { return (x + 255) / 256 * 256; }
constexpr size_t WS_H = 0;
constexpr size_t WS_RH = WS_H + al256((size_t)MTOK * DM * 2);
constexpr size_t WS_HN = WS_RH + al256((size_t)MTOK * 4);
constexpr size_t WS_U = WS_HN + al256((size_t)MTOK * DM * 2);
constexpr size_t WS_XT = WS_U + al256((size_t)MTOK * UW * 2);
constexpr size_t WS_DFT = WS_XT + al256((size_t)4096 * KD * 2);
constexpr size_t WS_Q = WS_DFT + al256((size_t)L * KF * 2);
constexpr size_t WS_KV = WS_Q + al256((size_t)MTOK * QW * 2);
constexpr size_t WS_WN = WS_KV + al256((size_t)MTOK * KVW * 2);
constexpr size_t WS_WF = WS_WN + al256((size_t)UW * DM * 2);
constexpr size_t WS_WQ = WS_WF + al256((size_t)512 * DM * 2);
constexpr size_t WS_WKV = WS_WQ + al256((size_t)768 * 384 * 2);
constexpr size_t WS_WO = WS_WKV + al256((size_t)1024 * 256 * 2);
constexpr size_t WS_RQ = WS_WO + al256((size_t)1024 * 1024 * 2);
constexpr size_t WS_RKV = WS_RQ + al256((size_t)MTOK * 4);
constexpr size_t WS_COS = WS_RKV + al256((size_t)MTOK * 4);
constexpr size_t WS_SIN = WS_COS + al256((size_t)L * 32 * 4);
constexpr size_t WS_CWF = WS_SIN + al256((size_t)L * 32 * 4);
constexpr size_t WS_SWF = WS_CWF + al256((size_t)DEPTH * 4 * 64 * 64 * 4);
constexpr size_t WS_PART = WS_SWF + al256((size_t)DEPTH * 4 * 64 * 64 * 4);
constexpr int PART_STRIDE = 16 * 128 + 32;
constexpr size_t WS_BAR = WS_PART + al256((size_t)256 * PART_STRIDE * 4);
constexpr size_t WS_END = WS_BAR + al256((size_t)3456 * 4);

constexpr int LDS_BYTES = 131072 + 4096 + 64;

__device__ __forceinline__ unsigned cvt_pk_bf16(float lo, float hi) { unsigned r; asm volatile("v_cvt_pk_bf16_f32 %0, %1, %2" : "=v"(r) : "v"(lo), "v"(hi)); return r; }
__device__ __forceinline__ int opaque_tid_w(int wave_s) { int t; asm volatile("v_mbcnt_lo_u32_b32 %0, -1, 0\n\tv_mbcnt_hi_u32_b32 %0, -1, %0" : "=&v"(t)); return (wave_s << 6) | t; }
__device__ __forceinline__ float opaque_zero() { float z; asm volatile("v_mov_b32 %0, 0" : "=v"(z)); return z; }
__device__ __forceinline__ float bf_lo(unsigned w) { return __uint_as_float(w << 16); }
__device__ __forceinline__ float bf_hi(unsigned w) { return __uint_as_float(w & 0xffff0000u); }
__device__ __forceinline__ float bf1(bf16_t x) { return __uint_as_float((unsigned)x << 16); }
__device__ __forceinline__ float wave_sum_l(float v, int lane) {
#pragma unroll
    for (int o = 1; o < 64; o <<= 1) v += __uint_as_float((unsigned)__builtin_amdgcn_ds_bpermute((lane ^ o) << 2, (int)__float_as_uint(v)));
    return v;
}
#define wave_sum(v) wave_sum_l((v), lane)
__device__ __forceinline__ float silu_f(float x) { return x * __builtin_amdgcn_rcpf(1.f + __expf(-x)); }
__device__ __forceinline__ u32x4 pack8(f32x4 a, f32x4 b) { u32x4 w; w.x = cvt_pk_bf16(a[0], a[1]); w.y = cvt_pk_bf16(a[2], a[3]); w.z = cvt_pk_bf16(b[0], b[1]); w.w = cvt_pk_bf16(b[2], b[3]); return w; }
__device__ __forceinline__ int rope_src(int jj) { const int g = jj >> 3, e = jj & 7; return e < 4 ? 4 * g + e : 28 + 4 * g + e; }

namespace pg8 {
constexpr int BM = 256, BK = 64, HALF = 128, HTB = HALF * BK * 2, NXCD = 8, WGM = 8;
__host__ __device__ __forceinline__ int lds_byte(int r, int c) { const int st = (r >> 4) * 2 + (c >> 5), rr = r & 15, cc = c & 31, ob = rr * 64 + cc * 2; return st * 1024 + (ob ^ (((ob >> 9) & 1) << 5)); }
__host__ __device__ __forceinline__ void stage_rc(int b, int& R, int& C) { const int st = b / 1024, sb = b % 1024, swz = sb ^ (((sb >> 9) & 1) << 5); R = (st >> 1) * 16 + swz / 64; C = (st & 1) * 32 + (swz % 64) / 2; }
__host__ __device__ __forceinline__ int perm32(int rho) { const int n = rho >> 4, i = rho & 15; return 8 * (i >> 2) + 4 * n + (i & 3); }
struct Unit { int pm, pn; };
struct Gemm { const bf16_t* A; const bf16_t* Bt; int M, N, K, lda, ldb; };
struct StaticOrder {
    int nM, nN, nwg, G, c;
    __device__ void init(int M, int N, int G_, int c_) { nM = M / BM; nN = N / BM; nwg = nM * nN; G = G_; c = c_; }
    __device__ bool next(int i, Unit& u) const {
        const long Lx = (long)i * G + c; if (Lx >= nwg) return false;
        int wgid = (int)Lx; { const int q = nwg / NXCD, r = nwg % NXCD, xcd = wgid % NXCD, off = wgid / NXCD; wgid = (xcd < r ? xcd * (q + 1) : r * (q + 1) + (xcd - r) * q) + off; }
        const int nig = WGM * nN, gid = wgid / nig, fm = gid * WGM, gsz = (nM - fm) < WGM ? (nM - fm) : WGM;
        u.pm = fm + ((wgid % nig) % gsz); u.pn = (wgid % nig) / gsz; return true;
    }
};
template <class Epi>
__device__ __forceinline__ void gemm_phase(LAS unsigned char* lds, const Gemm g, const StaticOrder& S, const Epi& E, int wave_s) {
    const int tid = opaque_tid_w(wave_s), wid = __builtin_amdgcn_readfirstlane(tid >> 6), lane = tid & 63, wr = wid >> 2, wc = wid & 3, fr = lane & 15, fq = lane >> 4;
    const int K = g.K, nt = K / BK;
    unsigned voffA[2], voffB[2];
#pragma unroll
    for (int i = 0; i < 2; ++i) { int R, C; stage_rc(tid * 16 + i * 8192, R, C); const int Rb = (R & ~31) + perm32(R & 31);
        voffA[i] = (unsigned)(R * g.lda + C) * 2u; voffB[i] = (unsigned)(Rb * g.ldb + C) * 2u; }
    const size_t kstep = (size_t)(BK * 2);
    const size_t hstepA = (size_t)HALF * g.lda * 2, hstepB = (size_t)HALF * g.ldb * 2;
    const size_t tstepA = 2 * hstepA, tstepB = 2 * hstepB;
    const unsigned ldsw = (unsigned)wid * 1024u;
    const int aoff = lds_byte(wr * 64 + fr, fq * 8), boff = lds_byte(wc * 32 + fr, fq * 8);
#define PG8_SA(b, h) (((b) * 2 + (h)) * HTB)
#define PG8_SB(b, h) ((4 + (b) * 2 + (h)) * HTB)
#define PG8_STAGE(bufoff, gbase, voff) do { _Pragma("unroll") for (int _i = 0; _i < 2; ++_i) \
        __builtin_amdgcn_global_load_lds((const unsigned*)((const char*)(gbase) + (voff)[_i]), (LAS unsigned*)(lds + (bufoff) + ldsw + _i * 8192), 16, 0, 0); } while (0)
#define PG8_LDA(dst, b, h) do { _Pragma("unroll") for (int m = 0; m < 4; ++m) _Pragma("unroll") for (int k = 0; k < 2; ++k) dst[m][k] = *(const LAS bf16x8*)(lds + PG8_SA(b, h) + aoff + m * 2048 + k * 1024); } while (0)
#define PG8_LDB(dst, b, h) do { _Pragma("unroll") for (int n = 0; n < 2; ++n) _Pragma("unroll") for (int k = 0; k < 2; ++k) dst[n][k] = *(const LAS bf16x8*)(lds + PG8_SB(b, h) + boff + n * 2048 + k * 1024); } while (0)
#define PG8_MMA(ai, bj, At, Bt) do { __builtin_amdgcn_s_setprio(1); _Pragma("unroll") for (int m = 0; m < 4; ++m) _Pragma("unroll") for (int n = 0; n < 2; ++n) _Pragma("unroll") for (int k = 0; k < 2; ++k) \
        acc[ai][bj][m][n] = __builtin_amdgcn_mfma_f32_16x16x32_bf16(Bt[n][k], At[m][k], acc[ai][bj][m][n], 0, 0, 0); __builtin_amdgcn_s_setprio(0); } while (0)
#define PG8_WAIT_V(n) asm volatile("s_waitcnt vmcnt(" #n ")" ::: "memory")
#define PG8_WAIT_L(n) asm volatile("s_waitcnt lgkmcnt(" #n ")" ::: "memory")
#define PG8_BAR __builtin_amdgcn_s_barrier()
#define PG8_SCHED __builtin_amdgcn_sched_barrier(0)
    Unit cur, nxt; int ui = 0;
    if (!S.next(0, cur)) return;
    f32x4 acc[2][2][4][2];
#pragma unroll
    for (int a = 0; a < 2; ++a)
#pragma unroll
        for (int b = 0; b < 2; ++b)
#pragma unroll
            for (int m = 0; m < 4; ++m)
#pragma unroll
                for (int n = 0; n < 2; ++n) { float z; asm volatile("v_mov_b32 %0, 0" : "=v"(z)); acc[a][b][m][n] = (f32x4){z, z, z, z}; }
    bf16x8 At[4][2], B0[2][2], B1[2][2];
    const char* cA = (const char*)g.A + (size_t)cur.pm * tstepA; const char* cB = (const char*)g.Bt + (size_t)cur.pn * tstepB;
    PG8_STAGE(PG8_SB(0, 0), cB, voffB); PG8_STAGE(PG8_SB(0, 1), cB + hstepB, voffB); PG8_STAGE(PG8_SA(0, 0), cA, voffA); PG8_STAGE(PG8_SA(0, 1), cA + hstepA, voffA);
    if (wr == 1) PG8_BAR;
    PG8_WAIT_V(2); PG8_BAR;
    PG8_STAGE(PG8_SB(1, 0), cB + kstep, voffB); PG8_STAGE(PG8_SA(1, 0), cA + kstep, voffA); PG8_STAGE(PG8_SB(1, 1), cB + hstepB + kstep, voffB);
    PG8_WAIT_V(6); PG8_BAR;
    for (;;) {
        const bool has_next = S.next(ui + 1, nxt);
        const char* nA = has_next ? (const char*)g.A + (size_t)nxt.pm * tstepA : cA; const char* nB = has_next ? (const char*)g.Bt + (size_t)nxt.pn * tstepB : cB;
#pragma unroll 1
        for (int t = 0; t < nt; t += 2) {
            const bool last = (t == nt - 2);
            const char* a1 = cA + (size_t)(t + 1) * kstep;
            const char* a2 = last ? nA : cA + (size_t)(t + 2) * kstep; const char* b2 = last ? nB : cB + (size_t)(t + 2) * kstep;
            const char* a3 = a2 + kstep; const char* b3 = b2 + kstep;
            PG8_LDB(B0, 0, 0); PG8_LDB(B1, 0, 1); PG8_SCHED; PG8_LDA(At, 0, 0); PG8_STAGE(PG8_SA(1, 1), a1 + hstepA, voffA);
            PG8_WAIT_V(8); PG8_WAIT_L(0); PG8_BAR; PG8_MMA(0, 0, At, B0); PG8_MMA(0, 1, At, B1); PG8_BAR; PG8_SCHED;
            PG8_LDA(At, 0, 1); PG8_STAGE(PG8_SB(0, 0), b2, voffB); PG8_STAGE(PG8_SB(0, 1), b2 + hstepB, voffB); PG8_STAGE(PG8_SA(0, 0), a2, voffA);
            PG8_WAIT_V(8); PG8_WAIT_L(0); PG8_BAR; PG8_MMA(1, 0, At, B0); PG8_MMA(1, 1, At, B1); PG8_BAR; PG8_SCHED;
            PG8_LDB(B0, 1, 0); PG8_LDB(B1, 1, 1); PG8_SCHED; PG8_LDA(At, 1, 0); PG8_STAGE(PG8_SA(0, 1), a2 + hstepA, voffA);
            PG8_WAIT_V(8); PG8_WAIT_L(0); PG8_BAR; PG8_MMA(0, 0, At, B0); PG8_MMA(0, 1, At, B1); PG8_BAR; PG8_SCHED;
            PG8_LDA(At, 1, 1); PG8_STAGE(PG8_SB(1, 0), b3, voffB); PG8_STAGE(PG8_SB(1, 1), b3 + hstepB, voffB); PG8_STAGE(PG8_SA(1, 0), a3, voffA);
            PG8_WAIT_V(8); PG8_WAIT_L(0); PG8_BAR; PG8_MMA(1, 0, At, B0); PG8_MMA(1, 1, At, B1); PG8_BAR; PG8_SCHED;
        }
        if (wr == 0) PG8_BAR;
        E(acc, cur, wr, wc, fr, fq);
        if (!has_next) break;
#pragma unroll
        for (int a = 0; a < 2; ++a)
#pragma unroll
            for (int b = 0; b < 2; ++b)
#pragma unroll
                for (int m = 0; m < 4; ++m)
#pragma unroll
                    for (int n = 0; n < 2; ++n) { float z; asm volatile("v_mov_b32 %0, 0" : "=v"(z)); acc[a][b][m][n] = (f32x4){z, z, z, z}; }
        cur = nxt; cA = nA; cB = nB; ++ui;
        if (wr == 1) PG8_BAR;
    }
    PG8_WAIT_V(0);
    PG8_BAR;
#undef PG8_SA
#undef PG8_SB
#undef PG8_STAGE
#undef PG8_LDA
#undef PG8_LDB
#undef PG8_MMA
#undef PG8_WAIT_V
#undef PG8_WAIT_L
#undef PG8_BAR
#undef PG8_SCHED
}
}
using pg8::Unit;
typedef const f32x4 (&AccRef)[2][2][4][2];

__device__ __forceinline__ void rope8(f32x4& v0, f32x4& v1, const float* cs, const float* sn, int pos, int g) {
    const f32x4 c = *(const f32x4*)(cs + pos * 32 + 4 * g), s = *(const f32x4*)(sn + pos * 32 + 4 * g);
    const f32x4 a = v0 * c - v1 * s, b = v1 * c + v0 * s; v0 = a; v1 = b;
}
struct EpiU {
    bf16_t* U; const float* cs; const float* sn; const float* rh;
    __device__ __forceinline__ void operator()(AccRef acc, const Unit& u, int wr, int wc, int fr, int fq) const {
        const int row0 = u.pm * 256 + wr * 64 + fr;
        float rsv[2][4];
#pragma unroll
        for (int ai = 0; ai < 2; ++ai)
#pragma unroll
            for (int m = 0; m < 4; ++m) rsv[ai][m] = rh[row0 + ai * 128 + m * 16];
#pragma unroll
        for (int bj = 0; bj < 2; ++bj) {
            const int blk = u.pn * 256 + bj * 128 + wc * 32, col0 = blk + 8 * fq;
            const bool dosilu = blk >= U_FG && !(blk >= U_PP && blk < U_PG);
            const bool dorope = blk >= U_KR && blk < U_KR + 64;
#pragma unroll
            for (int ai = 0; ai < 2; ++ai)
#pragma unroll
                for (int m = 0; m < 4; ++m) {
                    const int row = row0 + ai * 128 + m * 16;
                    f32x4 v0 = acc[ai][bj][m][0] * rsv[ai][m], v1 = acc[ai][bj][m][1] * rsv[ai][m];
                    if (dorope) rope8(v0, v1, cs, sn, row % L, (col0 - U_KR) >> 3);
                    if (dosilu) {
#pragma unroll
                        for (int e = 0; e < 4; ++e) { v0[e] = silu_f(v0[e]); v1[e] = silu_f(v1[e]); }
                    }
                    *(u32x4*)(U + (size_t)row * UW + col0) = pack8(v0, v1);
                    __builtin_amdgcn_sched_barrier(0);
                }
        }
    }
};
struct EpiXT {
    bf16_t* XT; const float* rh;
    __device__ __forceinline__ void operator()(AccRef acc, const Unit& u, int wr, int wc, int fr, int fq) const {
        const int row0 = u.pm * 256 + wr * 64 + fr;
#pragma unroll
        for (int bj = 0; bj < 2; ++bj) {
            const int t0 = u.pn * 256 + bj * 128 + wc * 32 + 8 * fq, b = t0 / L, l = t0 - b * L;
            const f32x4 ra = *(const f32x4*)(rh + t0), rb = *(const f32x4*)(rh + t0 + 4);
#pragma unroll
            for (int ai = 0; ai < 2; ++ai)
#pragma unroll
                for (int m = 0; m < 4; ++m) {
                    const int np = row0 + ai * 128 + m * 16;
                    *(u32x4*)(XT + (size_t)(b * 256 + (np & 255)) * KD + (np >> 8) * LP + l) = pack8(acc[ai][bj][m][0] * ra, acc[ai][bj][m][1] * rb);
                }
        }
    }
};
struct EpiDFT {
    bf16_t* MIX; const bf16_t* U;
    __device__ __forceinline__ void operator()(AccRef acc, const Unit& u, int wr, int wc, int fr, int fq) const {
        const int row0 = u.pm * 256 + wr * 64 + fr, b = u.pn;
#pragma unroll
        for (int ai = 0; ai < 2; ++ai) {
            u32x4 gt[4][2];
#pragma unroll
            for (int m = 0; m < 4; ++m)
#pragma unroll
                for (int bj = 0; bj < 2; ++bj) gt[m][bj] = *(const u32x4*)(U + ((size_t)b * L + row0 + ai * 128 + m * 16) * UW + U_FG + bj * 128 + wc * 32 + 8 * fq);
#pragma unroll
            for (int m = 0; m < 4; ++m)
#pragma unroll
                for (int bj = 0; bj < 2; ++bj) { const size_t tok = (size_t)b * L + row0 + ai * 128 + m * 16; const int n = bj * 128 + wc * 32 + 8 * fq; const u32x4 g = gt[m][bj];
                    f32x4 v0 = acc[ai][bj][m][0], v1 = acc[ai][bj][m][1];
                    v0[0] *= bf_lo(g.x); v0[1] *= bf_hi(g.x); v0[2] *= bf_lo(g.y); v0[3] *= bf_hi(g.y);
                    v1[0] *= bf_lo(g.z); v1[1] *= bf_hi(g.z); v1[2] *= bf_lo(g.w); v1[3] *= bf_hi(g.w);
                    *(u32x4*)(MIX + tok * DM + n) = pack8(v0, v1); }
            __builtin_amdgcn_sched_barrier(0);
        }
    }
};
struct EpiQ {
    bf16_t* Q; const float* rq; const float* cs; const float* sn;
    __device__ __forceinline__ void operator()(AccRef acc, const Unit& u, int wr, int wc, int fr, int fq) const {
        const int row0 = u.pm * 256 + wr * 64 + fr;
        float rsv[2][4];
#pragma unroll
        for (int ai = 0; ai < 2; ++ai)
#pragma unroll
            for (int m = 0; m < 4; ++m) rsv[ai][m] = rq[row0 + ai * 128 + m * 16];
#pragma unroll
        for (int bj = 0; bj < 2; ++bj) {
            const int blk = u.pn * 256 + bj * 128 + wc * 32, col0 = blk + 8 * fq, w = blk % 192;
            const bool dorope = w >= 128;
#pragma unroll
            for (int ai = 0; ai < 2; ++ai)
#pragma unroll
                for (int m = 0; m < 4; ++m) {
                    const int row = row0 + ai * 128 + m * 16; const float rs = rsv[ai][m];
                    f32x4 v0 = acc[ai][bj][m][0] * rs, v1 = acc[ai][bj][m][1] * rs;
                    if (dorope) rope8(v0, v1, cs, sn, row % L, (w - 128 + 8 * fq) >> 3);
                    *(u32x4*)(Q + (size_t)row * QW + col0) = pack8(v0, v1);
                    if (m == 3) __builtin_amdgcn_sched_barrier(0);
                }
        }
    }
};
struct EpiKV {
    bf16_t* KV; const float* rkv;
    __device__ __forceinline__ void operator()(AccRef acc, const Unit& u, int wr, int wc, int fr, int fq) const {
        const int row0 = u.pm * 256 + wr * 64 + fr;
        float rsv[2][4];
#pragma unroll
        for (int ai = 0; ai < 2; ++ai)
#pragma unroll
            for (int m = 0; m < 4; ++m) rsv[ai][m] = rkv[row0 + ai * 128 + m * 16];
#pragma unroll
        for (int ai = 0; ai < 2; ++ai)
#pragma unroll
            for (int m = 0; m < 4; ++m) {
                const int row = row0 + ai * 128 + m * 16; const float rs = rsv[ai][m];
#pragma unroll
                for (int bj = 0; bj < 2; ++bj) {
                    const int col0 = u.pn * 256 + bj * 128 + wc * 32 + 8 * fq;
                    *(u32x4*)(KV + (size_t)row * KVW + col0) = pack8(acc[ai][bj][m][0] * rs, acc[ai][bj][m][1] * rs);
                }
            }
    }
};
struct EpiOut {
    bf16_t* H;
    __device__ __forceinline__ void operator()(AccRef acc, const Unit& u, int wr, int wc, int fr, int fq) const {
        const int row0 = u.pm * 256 + wr * 64 + fr;
#pragma unroll
        for (int ai = 0; ai < 2; ++ai) {
            u32x4 hv[4][2];
#pragma unroll
            for (int m = 0; m < 4; ++m)
#pragma unroll
                for (int bj = 0; bj < 2; ++bj) hv[m][bj] = *(const u32x4*)(H + (size_t)(row0 + ai * 128 + m * 16) * DM + u.pn * 256 + bj * 128 + wc * 32 + 8 * fq);
#pragma unroll
            for (int m = 0; m < 4; ++m)
#pragma unroll
                for (int bj = 0; bj < 2; ++bj) { const u32x4 g = hv[m][bj]; f32x4 v0 = acc[ai][bj][m][0], v1 = acc[ai][bj][m][1];
                    v0[0] += bf_lo(g.x); v0[1] += bf_hi(g.x); v0[2] += bf_lo(g.y); v0[3] += bf_hi(g.y);
                    v1[0] += bf_lo(g.z); v1[1] += bf_hi(g.z); v1[2] += bf_lo(g.w); v1[3] += bf_hi(g.w);
                    *(u32x4*)(H + (size_t)(row0 + ai * 128 + m * 16) * DM + u.pn * 256 + bj * 128 + wc * 32 + 8 * fq) = pack8(v0, v1); }
            __builtin_amdgcn_sched_barrier(0);
        }
    }
};
struct EpiAll {
    int kind; unsigned char* ws;
    __device__ __forceinline__ void operator()(AccRef acc, const Unit& u, int wr, int wc, int fr, int fq) const {
        asm volatile("" : "+v"(fr), "+v"(fq));
        bf16_t* U = (bf16_t*)(ws + WS_U); const float* COS = (const float*)(ws + WS_COS); const float* SIN = (const float*)(ws + WS_SIN);
        switch (kind) {
            case 0: { EpiU E{U, COS, SIN, (const float*)(ws + WS_RH)}; E(acc, u, wr, wc, fr, fq); break; }
            case 1: { EpiXT E{(bf16_t*)(ws + WS_XT), (const float*)(ws + WS_RH)}; E(acc, u, wr, wc, fr, fq); break; }
            case 2: { EpiDFT E{(bf16_t*)(ws + WS_HN), U}; E(acc, u, wr, wc, fr, fq); break; }
            case 3: { EpiQ E{(bf16_t*)(ws + WS_Q), (const float*)(ws + WS_RQ), COS, SIN}; E(acc, u, wr, wc, fr, fq); break; }
            case 4: { EpiKV E{(bf16_t*)(ws + WS_KV), (const float*)(ws + WS_RKV)}; E(acc, u, wr, wc, fr, fq); break; }
            default: { EpiOut E{(bf16_t*)(ws + WS_H)}; E(acc, u, wr, wc, fr, fq); break; }
        }
    }
};

namespace att {
constexpr int NW = 8, QBLK = 32, KVBLK = 64, NT = 65;
constexpr float SCALE = 0.07216878364870322f, THR = 8.f;
constexpr int SHM_V = 16384, SHM_K = 16384, SHM_R = 8192;
constexpr int OFF_V = 0, OFF_K = 2 * SHM_V, OFF_R = OFF_K + 2 * SHM_K, OFF_WS = OFF_R + 2 * SHM_R, OFF_QR = OFF_WS + 2048;
#define KSWZ(row, colB) ((row) * 256 + ((colB) ^ (((row) & 7) << 4)))
#define RSWZ(row, colB) ((row) * 128 + ((colB) ^ (((row) & 7) << 4)))
#define SBAR() __builtin_amdgcn_sched_barrier(0)
__device__ __forceinline__ int crow(int r, int hi) { return (r & 3) + 8 * (r >> 2) + 4 * hi; }
__device__ __forceinline__ void partialSM(f32x16& p0, f32x16& p1, float& m_reg, float& mn, float& alpha) {
    constexpr float C = SCALE * 1.4426950408889634f;
    float pmax = p0[0];
#pragma unroll
    for (int r = 1; r < 16; ++r) pmax = fmaxf(pmax, p0[r]);
#pragma unroll
    for (int r = 0; r < 16; ++r) pmax = fmaxf(pmax, p1[r]);
    { auto rr = __builtin_amdgcn_permlane32_swap(__float_as_uint(pmax), __float_as_uint(pmax), false, false);
      pmax = fmaxf(__uint_as_float(rr[0]), __uint_as_float(rr[1])); }
    if (__builtin_expect(__all(pmax - m_reg <= THR / SCALE), 1)) { mn = m_reg; alpha = 1.f; }
    else { mn = fmaxf(m_reg, pmax); alpha = __builtin_amdgcn_exp2f((m_reg - mn) * C); m_reg = mn; }
    const float mnC = -mn * C;
#pragma unroll
    for (int r = 0; r < 16; ++r) p0[r] = fmaf(p0[r], C, mnC);
#pragma unroll
    for (int r = 0; r < 16; ++r) p1[r] = fmaf(p1[r], C, mnC);
#pragma unroll
    for (int r = 0; r < 16; ++r) p0[r] = __builtin_amdgcn_exp2f(p0[r]);
}
__device__ __forceinline__ void finishSM(f32x16& p0, f32x16& p1, float alpha, float& l_reg, bf16x8& pa0, bf16x8& pa1, bf16x8& pa2, bf16x8& pa3) {
#pragma unroll
    for (int r = 0; r < 16; ++r) p1[r] = __builtin_amdgcn_exp2f(p1[r]);
    float ps = 0;
#pragma unroll
    for (int r = 0; r < 16; ++r) ps += p0[r];
#pragma unroll
    for (int r = 0; r < 16; ++r) ps += p1[r];
    { auto rr = __builtin_amdgcn_permlane32_swap(__float_as_uint(ps), __float_as_uint(ps), false, false);
      ps = __uint_as_float(rr[0]) + __uint_as_float(rr[1]); }
    l_reg = l_reg * alpha + ps;
#define PK4(P, BASE, OUT) do { unsigned a0 = cvt_pk_bf16(P[BASE + 0], P[BASE + 1]), a1 = cvt_pk_bf16(P[BASE + 2], P[BASE + 3]);   \
    unsigned b0 = cvt_pk_bf16(P[BASE + 4], P[BASE + 5]), b1 = cvt_pk_bf16(P[BASE + 6], P[BASE + 7]);                              \
    auto r0 = __builtin_amdgcn_permlane32_swap(a0, b0, false, false); auto r1 = __builtin_amdgcn_permlane32_swap(a1, b1, false, false); \
    u32x4 w = {r0[0], r1[0], r0[1], r1[1]}; OUT = *reinterpret_cast<bf16x8*>(&w); } while (0)
    PK4(p0, 0, pa0); PK4(p0, 8, pa1); PK4(p1, 0, pa2); PK4(p1, 8, pa3);
#undef PK4
}
__device__ __forceinline__ void qkt(f32x16& p0, f32x16& p1, const char* Ks, const char* Rs, const bf16x8* qr, const char* qrl, int r32, int hi) {
    p0 = f32x16{}; p1 = f32x16{};
#pragma unroll
    for (int d0 = 0; d0 < 8; ++d0) { const int cb = (d0 * 16 + hi * 8) * 2;
        bf16x8 b0 = *reinterpret_cast<const bf16x8*>(Ks + KSWZ(r32, cb));
        bf16x8 b1 = *reinterpret_cast<const bf16x8*>(Ks + KSWZ(32 + r32, cb));
        p0 = __builtin_amdgcn_mfma_f32_32x32x16_bf16(b0, qr[d0], p0, 0, 0, 0);
        p1 = __builtin_amdgcn_mfma_f32_32x32x16_bf16(b1, qr[d0], p1, 0, 0, 0); }
#pragma unroll
    for (int d0 = 0; d0 < 4; ++d0) { const int cb = (d0 * 16 + hi * 8) * 2;
        bf16x8 b0 = *reinterpret_cast<const bf16x8*>(Rs + RSWZ(r32, cb));
        bf16x8 b1 = *reinterpret_cast<const bf16x8*>(Rs + RSWZ(32 + r32, cb));
        p0 = __builtin_amdgcn_mfma_f32_32x32x16_bf16(b0, qr[8 + d0], p0, 0, 0, 0);
        p1 = __builtin_amdgcn_mfma_f32_32x32x16_bf16(b1, qr[8 + d0], p1, 0, 0, 0); }
}
__device__ __forceinline__ void kmask(f32x16& p0, f32x16& p1, int k0, int hi) {
#pragma unroll
    for (int r = 0; r < 16; ++r) { const int kv = k0 + crow(r, hi); if (kv >= L) p0[r] = -1e30f; if (kv + 32 >= L) p1[r] = -1e30f; }
}
__device__ __forceinline__ int v_st(int k, int c) { const int kk = (k & ~0xC) | ((k & 4) << 1) | ((k & 8) >> 1); return ((kk >> 3) * 4 + (c >> 5)) * 512 + ((kk & 7) * 32 + (c & 31)) * 2; }
__device__ __forceinline__ int v_rd_base(int lane) { return ((lane & 3) << 3) | (((lane >> 2) & 3) << 6) | (((lane >> 4) & 1) << 5) | (((lane >> 5) & 1) << 8); }
constexpr int v_rd_off(int d0, int ks, int half) { return d0 * 512 + ks * 4096 + half * 2048; }
template <int OFF> __device__ __forceinline__ s16x4 tr_read(int vb) {
    s16x4 r; asm volatile("ds_read_b64_tr_b16 %0, %1 offset:%2" : "=&v"(r) : "v"(vb), "i"(OFF) : "memory"); return r;
}
template <int D0> __device__ __forceinline__ void pv_one(f32x16& od, int vb, bf16x8 pa0, bf16x8 pa1, bf16x8 pa2, bf16x8 pa3) {
    const s16x4 l0 = tr_read<v_rd_off(D0, 0, 0)>(vb), h0 = tr_read<v_rd_off(D0, 0, 1)>(vb), l1 = tr_read<v_rd_off(D0, 1, 0)>(vb), h1 = tr_read<v_rd_off(D0, 1, 1)>(vb);
    const s16x4 l2 = tr_read<v_rd_off(D0, 2, 0)>(vb), h2 = tr_read<v_rd_off(D0, 2, 1)>(vb), l3 = tr_read<v_rd_off(D0, 3, 0)>(vb), h3 = tr_read<v_rd_off(D0, 3, 1)>(vb);
    asm volatile("s_waitcnt lgkmcnt(0)" ::: "memory"); SBAR();
#define PK(Lx, Hx) (bf16x8){Lx[0], Lx[1], Lx[2], Lx[3], Hx[0], Hx[1], Hx[2], Hx[3]}
    od = __builtin_amdgcn_mfma_f32_32x32x16_bf16(pa0, PK(l0, h0), od, 0, 0, 0);
    od = __builtin_amdgcn_mfma_f32_32x32x16_bf16(pa1, PK(l1, h1), od, 0, 0, 0);
    od = __builtin_amdgcn_mfma_f32_32x32x16_bf16(pa2, PK(l2, h2), od, 0, 0, 0);
    od = __builtin_amdgcn_mfma_f32_32x32x16_bf16(pa3, PK(l3, h3), od, 0, 0, 0);
#undef PK
}
__device__ __forceinline__ void pv_d0(f32x16* o, int vb, bf16x8 pa0, bf16x8 pa1, bf16x8 pa2, bf16x8 pa3) {
    pv_one<0>(o[0], vb, pa0, pa1, pa2, pa3); pv_one<1>(o[1], vb, pa0, pa1, pa2, pa3); pv_one<2>(o[2], vb, pa0, pa1, pa2, pa3); pv_one<3>(o[3], vb, pa0, pa1, pa2, pa3);
}

__device__ __forceinline__ int swap23(int k) { return (k & ~0xC) | ((k & 4) << 1) | ((k & 8) >> 1); }
__device__ __forceinline__ void attn_unit(int b, int h, int qb, const bf16_t* __restrict__ Q, const bf16_t* __restrict__ KV, const bf16_t* __restrict__ U,
                                          bf16_t* __restrict__ MIX, char* lds, LAS unsigned char* ldsl, int t_begin, int t_end, float* __restrict__ part, int wave_s) {
    const int tid = opaque_tid_w(wave_s), wid = tid >> 6, lane = tid & 63, r32 = lane & 31, hi = lane >> 5;
    const int widu = __builtin_amdgcn_readfirstlane(wid);
    char* V_lds = lds + OFF_V; char* K_lds = lds + OFF_K; char* R_lds = lds + OFF_R;
    float* ws = (float*)(lds + OFF_WS) + wid * 64; float* li_l = ws; float* al_l = ws + 32;
    float m_reg = -1e30f, l_reg = 0; f32x16 o[4] = {}; bf16x8 qr[12];
    const char* qrl = nullptr;
    const size_t tok0 = (size_t)b * L;
    __syncthreads();
    { int qrow = qb * 256 + wid * QBLK + r32; if (qrow > L - 1) qrow = L - 1;
      const bf16_t* Qw = Q + (tok0 + qrow) * QW + h * 192 + hi * 8;
#pragma unroll
      for (int d0 = 0; d0 < 12; ++d0) qr[d0] = *(const bf16x8*)(Qw + d0 * 16); }
    const char* Kh = (const char*)(KV + tok0 * KVW + h * 256); const char* Vh = Kh + 256; const char* Rh = (const char*)(U + tok0 * UW + U_KR);
    int rowK[2], colK[2], keyV[2], colV[2];
#pragma unroll
    for (int i = 0; i < 2; ++i) { const int pc = 2 * wid + i; rowK[i] = 4 * pc + (lane >> 4); colK[i] = ((lane & 15) ^ (rowK[i] & 7)) * 16;
        const int off = pc * 1024 + lane * 16, st = off >> 9; keyV[i] = swap23((st >> 2) * 8 + ((off & 511) >> 6)); colV[i] = ((st & 3) * 32 + ((off >> 4) & 3) * 8) * 2; }
    const int rowR = 8 * wid + (lane >> 3), colR = ((lane & 7) ^ (rowR & 7)) * 16;
    const int vb0 = (int)(uintptr_t)V_lds + v_rd_base(lane);
#define CLK(k) ((k) < L ? (k) : L - 1)
#define DMA_KR(bb, k0) do { _Pragma("unroll") for (int _i = 0; _i < 2; ++_i) \
        __builtin_amdgcn_global_load_lds((const unsigned*)(Kh + (unsigned)(CLK((k0) + rowK[_i]) * (KVW * 2) + colK[_i])), (LAS unsigned*)(ldsl + OFF_K + (bb) * SHM_K + (2 * widu + _i) * 1024), 16, 0, 0); \
        __builtin_amdgcn_global_load_lds((const unsigned*)(Rh + (unsigned)(CLK((k0) + rowR) * (UW * 2) + colR)), (LAS unsigned*)(ldsl + OFF_R + (bb) * SHM_R + widu * 1024), 16, 0, 0); } while (0)
#define DMA_V(bb, k0) do { _Pragma("unroll") for (int _i = 0; _i < 2; ++_i) \
        __builtin_amdgcn_global_load_lds((const unsigned*)(Vh + (unsigned)(CLK((k0) + keyV[_i]) * (KVW * 2) + colV[_i])), (LAS unsigned*)(ldsl + OFF_V + (bb) * SHM_V + (2 * widu + _i) * 1024), 16, 0, 0); } while (0)
#define WAITBAR() do { asm volatile("s_waitcnt vmcnt(0) lgkmcnt(0)" ::: "memory"); __builtin_amdgcn_s_barrier(); asm volatile("" ::: "memory"); } while (0)
    const int N = t_end - t_begin;
    DMA_KR(0, t_begin * KVBLK); DMA_V(0, t_begin * KVBLK); DMA_KR(1, (t_begin + 1) * KVBLK);
    WAITBAR();
    if (part && widu != 0) {
        WAITBAR();
#pragma unroll 1
        for (int j = 0; j < N; ++j) { const int bb = j & 1, jt = t_begin + j;
            if (j + 1 < N) DMA_V(bb ^ 1, (jt + 1) * KVBLK);
            if (j + 2 < N) DMA_KR(bb, (jt + 2) * KVBLK);
            WAITBAR(); }
        return;
    }
    f32x16 pn0, pn1;
    qkt(pn0, pn1, K_lds, R_lds, qr, qrl, r32, hi);
    WAITBAR();
#define ATT_BODY(MASKED) do { const int bb = j & 1, jt = t_begin + j; \
        if (j + 1 < N) DMA_V(bb ^ 1, (jt + 1) * KVBLK); \
        if (j + 2 < N) DMA_KR(bb, (jt + 2) * KVBLK); \
        f32x16 p0 = pn0, p1 = pn1; float mn, al; bf16x8 pa0, pa1, pa2, pa3; \
        if (MASKED) kmask(p0, p1, jt * KVBLK, hi); \
        qkt(pn0, pn1, K_lds + (bb ^ 1) * SHM_K, R_lds + (bb ^ 1) * SHM_R, qr, qrl, r32, hi);     \
        partialSM(p0, p1, m_reg, mn, al); \
        if (__any(al < 1.f)) { if (hi == 0) al_l[r32] = al; asm volatile("s_waitcnt lgkmcnt(0)" ::: "memory"); \
            _Pragma("unroll") for (int d = 0; d < 4; ++d) _Pragma("unroll") for (int r = 0; r < 16; ++r) o[d][r] *= al_l[crow(r, hi)]; } \
        finishSM(p0, p1, al, l_reg, pa0, pa1, pa2, pa3); SBAR(); \
        pv_d0(o, vb0 + bb * SHM_V, pa0, pa1, pa2, pa3); \
        WAITBAR(); } while (0)
    int j = 0;
#pragma unroll 1
    for (; j < N && (t_begin + j + 1) * KVBLK <= L; ++j) ATT_BODY(false);
#pragma unroll 1
    for (; j < N; ++j) ATT_BODY(true);
#undef ATT_BODY
    if (part) {
        if (wid == 0) {
#pragma unroll
            for (int r = 0; r < 16; ++r) { const int orow = crow(r, hi);
                if (orow < 16) {
#pragma unroll
                    for (int d0 = 0; d0 < 4; ++d0) part[orow * 128 + d0 * 32 + r32] = o[d0][r]; } }
            if (lane < 16) { part[2048 + lane] = m_reg; part[2064 + lane] = l_reg; }
        }
        return;
    }
    if (hi == 0) li_l[r32] = l_reg; asm volatile("s_waitcnt lgkmcnt(0)" ::: "memory");
    const int rbase = qb * 256 + wid * QBLK;
#pragma unroll
    for (int rh = 0; rh < 2; ++rh) {
        unsigned short gt[8][4];
#pragma unroll
        for (int r8 = 0; r8 < 8; ++r8) { const int r = rh * 8 + r8, prow = min(rbase + crow(r, hi), L - 1); const size_t t = tok0 + prow;
#pragma unroll
            for (int d0 = 0; d0 < 4; ++d0) gt[r8][d0] = U[t * UW + U_AG + h * 128 + d0 * 32 + r32]; }
#pragma unroll
        for (int r8 = 0; r8 < 8; ++r8) { const int r = rh * 8 + r8, orow = crow(r, hi), prow = rbase + orow;
            const float rli = __builtin_amdgcn_rcpf(li_l[orow]);
            if (prow < L) { const size_t t = tok0 + prow;
#pragma unroll
                for (int d0 = 0; d0 < 4; ++d0) { const int c = h * 128 + d0 * 32 + r32;
                    const float ov = o[d0][r] * rli * bf1(gt[r8][d0]); MIX[t * DM + 512 + c] = (bf16_t)(cvt_pk_bf16(ov, ov) & 0xffffu); } } }
    }
#undef DMA_KR
#undef DMA_V
#undef WAITBAR
#undef CLK
}
}

struct Args {
    const float* x; const float* meta; const float* norm_w; const float* w_in; const float* fourier_w; const float* pool_w; const float* pool_scale;
    const float* q_norm_w; const float* w_uq; const float* kv_norm_w; const float* w_ukv; const float* w_out; const float* final_norm_w;
    float* out; unsigned char* ws; int ph_lo, ph_hi;
};

__device__ __forceinline__ float wsrc(const Args& a, int layer, int mat, int k, int j) {
    const float* w_in = a.w_in + (size_t)layer * DM * DIN + (size_t)k * DIN;
    if (mat == 0) {
        const float nw = a.norm_w[layer * DM + k];
        if (j < 384) return w_in[1024 + j] * nw;
        if (j < 448) return w_in[1664 + rope_src(j - 384)] * nw;
        if (j < 512) return 0.f;
        if (j < 768) return w_in[1408 + j - 512] * nw;
        if (j < 1024) return w_in[256 + j - 768] * nw;
        if (j < 1280) return 0.f;
        if (j < 1536) return w_in[768 + j - 1280] * nw;
        return w_in[1728 + j - 1536] * nw;
    } else if (mat == 1) {
        return 0.f;
    } else if (mat == 2) {
        const int hh = j / 192, w = j % 192; const int col = w < 128 ? j : hh * 192 + 128 + rope_src(w - 128);
        return a.w_uq[((size_t)layer * 384 + k) * 768 + col] * a.q_norm_w[layer * 384 + k];
    } else if (mat == 3) {
        return a.w_ukv[((size_t)layer * 256 + k) * 1024 + j] * a.kv_norm_w[layer * 256 + k];
    }
    return a.w_out[((size_t)layer * 1024 + k) * 1024 + j];
}
__device__ __forceinline__ void prep_item(const Args& a, int layer, int mat, int K, bf16_t* WT, int item, int nblk, LAS float* scr, int lane) {
    const int kb = item / nblk, nb = item % nblk, k0 = 64 * kb, n0 = 32 * nb;
#pragma unroll 1
    for (int i0 = 0; i0 < 32; i0 += 8) { float tv[8];
#pragma unroll
        for (int e = 0; e < 8; ++e) tv[e] = wsrc(a, layer, mat, k0 + 2 * (i0 + e) + (lane >> 5), n0 + (lane & 31));
#pragma unroll
        for (int e = 0; e < 8; ++e) scr[(2 * (i0 + e) + (lane >> 5)) * 33 + (lane & 31)] = tv[e]; }
    asm volatile("s_waitcnt lgkmcnt(0)" ::: "memory");
    const int c = lane & 7;
#pragma unroll
    for (int jx = 0; jx < 4; ++jx) { const int n = (lane >> 3) + 8 * jx; const LAS float* s = scr + (8 * c) * 33 + n;
        u32x4 o; o.x = cvt_pk_bf16(s[0 * 33], s[1 * 33]); o.y = cvt_pk_bf16(s[2 * 33], s[3 * 33]); o.z = cvt_pk_bf16(s[4 * 33], s[5 * 33]); o.w = cvt_pk_bf16(s[6 * 33], s[7 * 33]);
        *(u32x4*)(WT + (size_t)(n0 + n) * K + k0 + 8 * c) = o; }
    asm volatile("s_waitcnt lgkmcnt(0)" ::: "memory");
}


__device__ __forceinline__ void fold_item(const float* __restrict__ w_in_l, const float* __restrict__ nw, const float* __restrict__ F, float fscale, int base, bf16_t* WT, int row0, int k0, int lane) {
    float Freg[64];
#pragma unroll
    for (int c = 0; c < 64; ++c) Freg[c] = F[c * 64 + lane] * fscale;
#pragma unroll 1
    for (int kk0 = 0; kk0 < 64; kk0 += 8) {
        float av[8], acc[8];
#pragma unroll
        for (int e = 0; e < 8; ++e) { av[e] = w_in_l[(size_t)(k0 + kk0 + e) * DIN + base + lane]; acc[e] = 0.f; }
#pragma unroll
        for (int c = 0; c < 64; ++c) { const float f = Freg[c];
#pragma unroll
            for (int e = 0; e < 8; ++e) acc[e] += __uint_as_float((unsigned)__builtin_amdgcn_readlane((int)__float_as_uint(av[e]), c)) * f; }
#pragma unroll
        for (int e = 0; e < 8; ++e) acc[e] *= nw[k0 + kk0 + e];
        u32x4 o; o.x = cvt_pk_bf16(acc[0], acc[1]); o.y = cvt_pk_bf16(acc[2], acc[3]); o.z = cvt_pk_bf16(acc[4], acc[5]); o.w = cvt_pk_bf16(acc[6], acc[7]);
        *(u32x4*)(WT + (size_t)(row0 + lane) * 1024 + k0 + kk0) = o;
    }
}


#define XB_TMO      128
#define XB_XCNT(j)  (256  + 64 * (j))
#define XB_XSUB(j)  (1280 + 64 * (j))
#define XB_XGEN(j)  (2304 + 64 * (j))
#define XB_TOP      3328
#define XB_TOPGEN   3392
#define XCD_BAR_WORDS 3456
#define XB_SPIN_CAP (1u << 18)
__device__ __forceinline__ unsigned xb_ld(unsigned* p)              { return __hip_atomic_load(p, __ATOMIC_RELAXED, __HIP_MEMORY_SCOPE_AGENT); }
__device__ __forceinline__ unsigned xb_add(unsigned* p, unsigned v) { return __hip_atomic_fetch_add(p, v, __ATOMIC_RELAXED, __HIP_MEMORY_SCOPE_AGENT); }
__device__ __forceinline__ unsigned xb_xcc_id() { return (unsigned)__builtin_amdgcn_s_getreg((3 << 11) | 20) & 0xFu; }
#define XB_SPIN(cond, bar) do { unsigned _sp = 0; while (cond) { __builtin_amdgcn_s_sleep(1); \
    if ((++_sp & 255u) == 0u) { if (xb_ld(&(bar)[XB_TMO])) break; if (_sp > XB_SPIN_CAP) { atomicAdd(&(bar)[XB_TMO], 1u); break; } } } } while (0)
__device__ __forceinline__ void xcd_barrier_complete(unsigned* bar, unsigned x, unsigned& nloc, unsigned& nx) {
    const unsigned G = gridDim.x;
    unsigned sum, cnt, mine, sp = 0u;
    for (;;) {
        sum = 0u; cnt = 0u; mine = 0u;
#pragma unroll
        for (unsigned j = 0; j < 16; ++j) { const unsigned c = xb_ld(&bar[XB_XCNT(j)]); sum += c; cnt += (c > 0u) ? 1u : 0u; mine = (j == x) ? c : mine; }
        if (sum == G) break;
        __builtin_amdgcn_s_sleep(1);
        if ((++sp & 255u) == 0u) { if (xb_ld(&bar[XB_TMO])) break; if (sp > XB_SPIN_CAP) { atomicAdd(&bar[XB_TMO], 1u); break; } }
    }
    nloc = mine > 0u ? mine : 1u; nx = cnt > 0u ? cnt : 1u;
}
__device__ __forceinline__ void xcd_barrier(unsigned* bar, volatile LAS unsigned* st, bool leader) {
    asm volatile("s_waitcnt vmcnt(0)" ::: "memory");
    __syncthreads();
    if (leader) {
        const unsigned x = xb_xcc_id();
        __builtin_amdgcn_s_waitcnt(0);
        unsigned nloc = st[0], nx = st[1];
        if (nloc == 0u) { xcd_barrier_complete(bar, x, nloc, nx); st[0] = nloc; st[1] = nx; }
        const unsigned old = xb_add(&bar[XB_XSUB(x)], 1u);
        const unsigned gen = old / nloc;
        if (old + 1u == (gen + 1u) * nloc) {
            __builtin_amdgcn_fence(__ATOMIC_RELEASE, "agent");
            asm volatile("s_waitcnt vmcnt(0)" ::: "memory");
            const unsigned og = xb_add(&bar[XB_TOP], 1u);
            const unsigned tg = og / nx;
            if (og + 1u == (tg + 1u) * nx) xb_add(&bar[XB_TOPGEN], 1u);
            else XB_SPIN(xb_ld(&bar[XB_TOPGEN]) == tg, bar);
            __builtin_amdgcn_fence(__ATOMIC_ACQUIRE, "agent");
            xb_add(&bar[XB_XGEN(x)], 1u);
            asm volatile("s_waitcnt vmcnt(0)" ::: "memory");
        } else {
            XB_SPIN(xb_ld(&bar[XB_XGEN(x)]) == gen, bar);
            __builtin_amdgcn_fence(__ATOMIC_ACQUIRE, "agent");
            asm volatile("s_waitcnt vmcnt(0)" ::: "memory");
        }
    }
    __syncthreads();
}

#ifndef PHMASK
#define PHMASK 0xFF
#endif
#define PHM(k) ((PHMASK >> (k)) & 1)
#ifndef Q3
#define Q3 15
#endif
__global__ void __launch_bounds__(512) hymba_fwd(Args a) {
    extern __shared__ __attribute__((aligned(16))) unsigned char lds[];
    cg::grid_group grid = cg::this_grid();
    const int wave_s = __builtin_amdgcn_readfirstlane((int)threadIdx.x >> 6);
    if (threadIdx.x == 0) { volatile LAS unsigned* xst0 = (volatile LAS unsigned*)((LAS unsigned char*)lds + 135168); xst0[0] = 0u; xst0[1] = 0u;
        (void)xb_add(&((unsigned*)(a.ws + WS_BAR))[XB_XCNT(xb_xcc_id())], 1u); }
    __syncthreads();
#pragma unroll 1
    for (int ph = a.ph_lo; ph < a.ph_hi; ++ph) {
    size_t wz = 0; asm volatile("" : "+s"(wz));
    unsigned char* ws = a.ws + wz;
    const int tid = opaque_tid_w(wave_s), lane = tid & 63, wave = __builtin_amdgcn_readfirstlane(tid >> 6);
    int G = gridDim.x, bx = blockIdx.x; asm volatile("" : "+s"(G), "+s"(bx));
    const int vcu = (G % 8 == 0) ? (bx % 8) * (G / 8) + bx / 8 : bx;
    const int gw = vcu * 8 + wave, NGW = G * 8;
    bf16_t* H = (bf16_t*)(ws + WS_H); float* RH = (float*)(ws + WS_RH); bf16_t* MIX = (bf16_t*)(ws + WS_HN); bf16_t* U = (bf16_t*)(ws + WS_U);
    bf16_t* XT = (bf16_t*)(ws + WS_XT); bf16_t* DFT = (bf16_t*)(ws + WS_DFT); bf16_t* Qb = (bf16_t*)(ws + WS_Q); bf16_t* KVb = (bf16_t*)(ws + WS_KV);
    bf16_t* WN = (bf16_t*)(ws + WS_WN); bf16_t* WF = (bf16_t*)(ws + WS_WF); bf16_t* WQ = (bf16_t*)(ws + WS_WQ); bf16_t* WKV = (bf16_t*)(ws + WS_WKV); bf16_t* WO = (bf16_t*)(ws + WS_WO);
    float* RQ = (float*)(ws + WS_RQ); float* RKV = (float*)(ws + WS_RKV); float* COS = (float*)(ws + WS_COS); float* SIN = (float*)(ws + WS_SIN);
    float* CWF = (float*)(ws + WS_CWF); float* SWF = (float*)(ws + WS_SWF);
    LAS unsigned char* ldsl = (LAS unsigned char*)lds;
    {
        if (ph == 0 && PHM(6)) {
            float* tabc = (float*)lds; float* tabs = tabc + L;
            for (int m = tid; m < L; m += 512) { float s, c; sincospif(2.0f * (float)m / (float)L, &s, &c); tabc[m] = c; tabs[m] = s; }
            __syncthreads();
            for (int k = bx; k < L; k += G) {
                bf16_t* row = DFT + (size_t)k * KF;
                for (int ch = tid; ch < KF / 8; ch += 512) {
                    const int c0 = ch * 8, hs = c0 >= LF, l0 = c0 - hs * LF;
                    int idx = (int)(((long)k * l0) % L); float v[8];
#pragma unroll
                    for (int e = 0; e < 8; ++e) { const bool ok = (l0 + e) <= LH; v[e] = ok ? (hs ? -tabs[idx] : tabc[idx]) : 0.f; idx += k; if (idx >= L) idx -= L; }
                    u32x4 o; o.x = cvt_pk_bf16(v[0], v[1]); o.y = cvt_pk_bf16(v[2], v[3]); o.z = cvt_pk_bf16(v[4], v[5]); o.w = cvt_pk_bf16(v[6], v[7]);
                    *(u32x4*)(row + c0) = o;
                }
            }
            for (int i = bx * 512 + tid; i < L * 32; i += G * 512) { const int pos = i >> 5, ii = i & 31;
                const float inv = 1.0f / powf(10000.0f, (float)(2 * ii) / 64.0f); const float ang = (float)pos * inv; float s, c; sincosf(ang, &s, &c); COS[i] = c; SIN[i] = s; }
            for (int i = bx * 512 + tid; i < DEPTH * 4 * 64 * 64; i += G * 512) { const int d = i & 63, c = (i >> 6) & 63, lh = i >> 12;
                const float* Wf = a.fourier_w + (size_t)lh * 4096 + d; float sc_ = 0.f, ss_ = 0.f;
                for (int e = 0; e < 64; ++e) { float s, cc; sincospif((float)((c * e) & 63) / 32.0f, &s, &cc); const float w = Wf[e * 64]; sc_ += cc * w; ss_ += s * w; }
                const float nrm = rsqrtf((float)L * 64.0f); CWF[i] = sc_ * nrm; SWF[i] = ss_ * nrm; }
            for (int i = bx * 512 + tid; i < 4096 * 2 * 14; i += G * 512) { const int ch = i % 14, hs = (i / 14) & 1, r = i / 28;
                const unsigned z = __float_as_uint(opaque_zero()); *(u32x4*)(XT + (size_t)r * KD + hs * LP + L + ch * 8) = (u32x4){z, z, z, z}; }
            __syncthreads();
        } else if (ph == 1 + 6 * DEPTH && PHM(7)) {
            for (int r = gw; r < NB * SEQ; r += NGW) { const int b = r >> 12, s = r & 4095;
                const u32x4* xr = (const u32x4*)(H + ((size_t)b * L + NMETA + s) * DM) + lane; const u32x4 x0 = xr[0], x1 = xr[64];
                float v[16]; v[0] = bf_lo(x0.x); v[1] = bf_hi(x0.x); v[2] = bf_lo(x0.y); v[3] = bf_hi(x0.y); v[4] = bf_lo(x0.z); v[5] = bf_hi(x0.z); v[6] = bf_lo(x0.w); v[7] = bf_hi(x0.w);
                v[8] = bf_lo(x1.x); v[9] = bf_hi(x1.x); v[10] = bf_lo(x1.y); v[11] = bf_hi(x1.y); v[12] = bf_lo(x1.z); v[13] = bf_hi(x1.z); v[14] = bf_lo(x1.w); v[15] = bf_hi(x1.w);
                float ss = 0.f;
#pragma unroll
                for (int e = 0; e < 16; ++e) ss += v[e] * v[e];
                const float rstd = rsqrtf(wave_sum(ss) * (1.f / DM) + NORM_EPS);
                float* orow = a.out + (size_t)r * DM; const float* fw = a.final_norm_w;
#pragma unroll
                for (int hlf = 0; hlf < 2; ++hlf) { const int c0 = hlf * 512 + lane * 8; const f32x4 w0 = *(const f32x4*)(fw + c0), w1 = *(const f32x4*)(fw + c0 + 4);
                    f32x4 o0 = {v[hlf * 8 + 0] * rstd * w0[0], v[hlf * 8 + 1] * rstd * w0[1], v[hlf * 8 + 2] * rstd * w0[2], v[hlf * 8 + 3] * rstd * w0[3]};
                    f32x4 o1 = {v[hlf * 8 + 4] * rstd * w1[0], v[hlf * 8 + 5] * rstd * w1[1], v[hlf * 8 + 6] * rstd * w1[2], v[hlf * 8 + 7] * rstd * w1[3]};
                    *(f32x4*)(orow + c0) = o0; *(f32x4*)(orow + c0 + 4) = o1; } }
        } else if (ph > 0 && ph < 1 + 6 * DEPTH) {
            const int layer = (ph - 1) / 6, kind = (ph - 1) % 6;
            if (kind == 0 && PHM(0)) {
                LAS float* scr = (LAS float*)(ldsl + wave * 8448);
                constexpr int I0 = 16 * 64, IF = 192, I2 = 6 * 24, I3 = 4 * 32, I4 = 16 * 32;
                for (int it = gw; it < IF + I0 + I2 + I3 + I4; it += NGW) { int r = it;
                    if (r < IF) {
                        const float* w_in_l = a.w_in + (size_t)layer * DM * DIN; const float* nw = a.norm_w + layer * DM; const int kb = r & 15, part = r >> 4;
                        if (part < 4) fold_item(w_in_l, nw, a.pool_w + (size_t)(layer * 4 + part) * 4096, a.pool_scale[layer * 256 + part * 64 + lane], 512 + part * 64, WN, 1024 + part * 64, kb * 64, lane);
                        else { const int pp = part - 4, hh = pp & 3, sn = pp >> 2;
                            fold_item(w_in_l, nw, (sn ? SWF : CWF) + (size_t)(layer * 4 + hh) * 4096, 1.f, hh * 64, WF, sn * 256 + hh * 64, kb * 64, lane); }
                        continue; } r -= IF;
                    if (r < I0) { if ((r & 63) < 32 || (r & 63) >= 40) prep_item(a, layer, 0, 1024, WN, r, 64, scr, lane); continue; } r -= I0;
                    if (r < I2) { prep_item(a, layer, 2, 384, WQ, r, 24, scr, lane); continue; } r -= I2;
                    if (r < I3) { prep_item(a, layer, 3, 256, WKV, r, 32, scr, lane); continue; } r -= I3;
                    prep_item(a, layer, 4, 1024, WO, r, 32, scr, lane); }
                if (layer == 0) {
                    for (int r0 = gw * 4; r0 < MTOK; r0 += NGW * 4) {
                        f32x4 v[4][4]; float ss[4];
#pragma unroll
                        for (int q = 0; q < 4; ++q) { const int r = r0 + q; const int b = r / L, l = r - b * L;
                            const float* src = l < NMETA ? a.meta + (size_t)l * DM : a.x + ((size_t)b * SEQ + l - NMETA) * DM;
                            const f32x4* xr = (const f32x4*)src + lane;
#pragma unroll
                            for (int j = 0; j < 4; ++j) v[q][j] = xr[64 * j]; }
#pragma unroll
                        for (int q = 0; q < 4; ++q) { float t = 0.f;
#pragma unroll
                            for (int j = 0; j < 4; ++j) t += v[q][j].x * v[q][j].x + v[q][j].y * v[q][j].y + v[q][j].z * v[q][j].z + v[q][j].w * v[q][j].w;
                            ss[q] = t; }
#pragma unroll
                        for (int o = 1; o < 64; o <<= 1) {
#pragma unroll
                            for (int q = 0; q < 4; ++q) ss[q] += __uint_as_float((unsigned)__builtin_amdgcn_ds_bpermute((lane ^ o) << 2, (int)__float_as_uint(ss[q]))); }
#pragma unroll
                        for (int q = 0; q < 4; ++q) { const int r = r0 + q;
                            if (lane == 0) RH[r] = rsqrtf(ss[q] * (1.f / DM) + NORM_EPS);
                            u32x2* o8 = (u32x2*)(H + (size_t)r * DM) + lane;
#pragma unroll
                            for (int j = 0; j < 4; ++j) { u32x2 w; w.x = cvt_pk_bf16(v[q][j].x, v[q][j].y); w.y = cvt_pk_bf16(v[q][j].z, v[q][j].w); o8[64 * j] = w; } }
                    }
                } else {
                    for (int r0 = gw * 8; r0 < MTOK; r0 += NGW * 8) {
                        u32x4 v[8][2]; float ss[8];
#pragma unroll
                        for (int q = 0; q < 8; ++q) { const u32x4* xr = (const u32x4*)(H + (size_t)(r0 + q) * DM) + lane; v[q][0] = xr[0]; v[q][1] = xr[64]; }
#pragma unroll
                        for (int q = 0; q < 8; ++q) { float t = 0.f;
#pragma unroll
                            for (int j = 0; j < 2; ++j) { const u32x4 x = v[q][j]; float e;
                                e = bf_lo(x.x); t += e * e; e = bf_hi(x.x); t += e * e; e = bf_lo(x.y); t += e * e; e = bf_hi(x.y); t += e * e;
                                e = bf_lo(x.z); t += e * e; e = bf_hi(x.z); t += e * e; e = bf_lo(x.w); t += e * e; e = bf_hi(x.w); t += e * e; }
                            ss[q] = t; }
#pragma unroll
                        for (int o = 1; o < 64; o <<= 1) {
#pragma unroll
                            for (int q = 0; q < 8; ++q) ss[q] += __uint_as_float((unsigned)__builtin_amdgcn_ds_bpermute((lane ^ o) << 2, (int)__float_as_uint(ss[q]))); }
                        if (lane < 8) { float sv = ss[0];
#pragma unroll
                            for (int q = 1; q < 8; ++q) sv = (lane == q) ? ss[q] : sv;
                            RH[r0 + lane] = rsqrtf(sv * (1.f / DM) + NORM_EPS); }
                    }
                }
            } else if ((kind == 1 || kind == 3 || kind == 5) && PHM(1)) {
                const int j0 = kind == 1 ? 0 : (kind == 3 ? 2 : 5), j1 = kind == 1 ? 2 : (kind == 3 ? 5 : 6);
                if (kind == 5) {
                    const float* PART = (const float*)(ws + WS_PART);
                    for (int gi = bx * 512 + tid; gi < 64 * 16 * 128; gi += G * 512) { const int col = gi & 127, row = (gi >> 7) & 15, bh = gi >> 11; constexpr float C = att::SCALE * 1.4426950408889634f;
                        const float* p0 = PART + (size_t)(bh * 4) * PART_STRIDE; float m = -1e30f;
#pragma unroll
                        for (int q = 0; q < 4; ++q) m = fmaxf(m, p0[q * PART_STRIDE + 2048 + row]);
                        float lsum = 0.f, osum = 0.f;
#pragma unroll
                        for (int q = 0; q < 4; ++q) { const float w = __builtin_amdgcn_exp2f((p0[q * PART_STRIDE + 2048 + row] - m) * C); lsum += p0[q * PART_STRIDE + 2064 + row] * w; osum += p0[q * PART_STRIDE + row * 128 + col] * w; }
                        const size_t t = (size_t)(bh >> 2) * L + 4096 + row; const int c = (bh & 3) * 128 + col;
                        const float ov = osum / lsum * bf1(U[t * UW + U_AG + c]); MIX[t * DM + 512 + c] = (bf16_t)(cvt_pk_bf16(ov, ov) & 0xffffu); }
                    asm volatile("s_waitcnt vmcnt(0) lgkmcnt(0)" ::: "memory");
                    xcd_barrier((unsigned*)(ws + WS_BAR), (volatile LAS unsigned*)(ldsl + 135168), tid == 0);
                }
#pragma unroll 1
                for (int jb = j0; jb < j1; ++jb) {
                    pg8::Gemm g;
                    if (jb == 0)      g = pg8::Gemm{H, WN, MTOK, UW, DM, DM, DM};
                    else if (jb == 1) g = pg8::Gemm{WF, H, 512, MTOK, DM, DM, DM};
                    else if (jb == 2) g = pg8::Gemm{DFT, XT, 4096, 4096, KF, KF, KD};
                    else if (jb == 3) g = pg8::Gemm{U + U_CQ, WQ, MTOK, QW, 384, UW, 384};
                    else if (jb == 4) g = pg8::Gemm{U + U_CKV, WKV, MTOK, KVW, 256, UW, 256};
                    else              g = pg8::Gemm{MIX, WO, MTOK, DM, DM, DM, DM};
                    const int rot = (jb == 1 || jb == 4) ? 8 : (jb == 3 ? 16 : 0);
                    pg8::StaticOrder S; S.init(g.M, g.N, G, (bx + G - rot) % G); EpiAll E{jb, ws};
                    pg8::gemm_phase<EpiAll>(ldsl, g, S, E, wave_s);
                    if (jb == 2) {
                for (int it = vcu; it < 256; it += G) {
                    const int fr = lane & 15, fq = lane >> 4;
                    const bf16_t* ap = DFT + (size_t)(4096 + fr) * KF + wave * 544 + fq * 8;
                    const bf16_t* bp = XT + (size_t)(it * 16 + fr) * KD + wave * 544 + fq * 8;
                    const float z0 = opaque_zero(); f32x4 c = {z0, z0, z0, z0};
#pragma unroll
                    for (int s0 = 0; s0 < 18; s0 += 6) { bf16x8 av[6], bv[6];
#pragma unroll
                        for (int e = 0; e < 6; ++e) if (s0 + e < 17) { av[e] = *(const bf16x8*)(ap + (s0 + e) * 32); bv[e] = *(const bf16x8*)(bp + (s0 + e) * 32); }
#pragma unroll
                        for (int e = 0; e < 6; ++e) if (s0 + e < 17) c = __builtin_amdgcn_mfma_f32_16x16x32_bf16(av[e], bv[e], c, 0, 0, 0); }
                    float* red = (float*)lds;
                    __syncthreads();
#pragma unroll
                    for (int j = 0; j < 4; ++j) red[wave * 256 + (fq * 4 + j) * 16 + fr] = c[j];
                    __syncthreads();
                    if (tid < 256) { float s = 0.f;
#pragma unroll
                        for (int w = 0; w < 8; ++w) s += red[w * 256 + tid];
                        const int kr = tid >> 4, cc = it * 16 + (tid & 15), b = cc >> 8, n = cc & 255; const size_t tok = (size_t)b * L + 4096 + kr;
                        const float gt = bf1(U[tok * UW + U_FG + n]);
                        { const float sv = s * gt; MIX[tok * DM + n] = (bf16_t)(cvt_pk_bf16(sv, sv) & 0xffffu); } }
                    __syncthreads();
                }
                    }
                }
            } else if (kind == 2 && PHM(2)) {
                for (int pr = gw; pr < MTOK / 2; pr += NGW) {
                    const int t0 = pr * 2;
#pragma unroll
                    for (int q = 0; q < 2; ++q) { const bf16_t* row = U + (size_t)(t0 + q) * UW;
                        const u32x4 x = *(const u32x4*)(row + lane * 8); float sq = 0.f, sk = 0.f;
                        if (lane < 48) { float e; e = bf_lo(x.x); sq += e * e; e = bf_hi(x.x); sq += e * e; e = bf_lo(x.y); sq += e * e; e = bf_hi(x.y); sq += e * e;
                                         e = bf_lo(x.z); sq += e * e; e = bf_hi(x.z); sq += e * e; e = bf_lo(x.w); sq += e * e; e = bf_hi(x.w); sq += e * e; }
                        if (lane < 32) { const u32x4 y = *(const u32x4*)(row + U_CKV + lane * 8); float e;
                                         e = bf_lo(y.x); sk += e * e; e = bf_hi(y.x); sk += e * e; e = bf_lo(y.y); sk += e * e; e = bf_hi(y.y); sk += e * e;
                                         e = bf_lo(y.z); sk += e * e; e = bf_hi(y.z); sk += e * e; e = bf_lo(y.w); sk += e * e; e = bf_hi(y.w); sk += e * e; }
                        sq = wave_sum(sq); sk = wave_sum(sk);
                        if (lane == 0) { RQ[t0 + q] = rsqrtf(sq * (1.f / 384.f) + NORM_EPS); RKV[t0 + q] = rsqrtf(sk * (1.f / 256.f) + NORM_EPS); } }
                    const int t = t0 + (lane >> 5), cgp = lane & 31, b = t / L, l = t - b * L, gI = cgp >> 3, half = 1 << gI;
                    const int lo = max(l - half, 0), hi = min(l + half, L);
                    float s[8] = {0.f, 0.f, 0.f, 0.f, 0.f, 0.f, 0.f, 0.f};
                    const bf16_t* base = U + (size_t)b * L * UW + U_PP + cgp * 8;
                    u32x4 xw[16];
#pragma unroll
                    for (int i = 0; i < 16; ++i) { int tt = l - 8 + i; tt = tt < 0 ? 0 : (tt > L - 1 ? L - 1 : tt); xw[i] = *(const u32x4*)(base + (size_t)tt * UW); }
#pragma unroll
                    for (int i = 0; i < 16; ++i) { const int tt = l - 8 + i; const float wgt = (tt >= lo && tt < hi) ? 1.f : 0.f; const u32x4 x = xw[i];
                        s[0] += wgt * bf_lo(x.x); s[1] += wgt * bf_hi(x.x); s[2] += wgt * bf_lo(x.y); s[3] += wgt * bf_hi(x.y); s[4] += wgt * bf_lo(x.z); s[5] += wgt * bf_hi(x.z); s[6] += wgt * bf_lo(x.w); s[7] += wgt * bf_hi(x.w); }
                    const float ic = 1.f / (float)(hi - lo);
                    const u32x4 xs = *(const u32x4*)(base + (size_t)l * UW); const u32x4 gt = *(const u32x4*)(U + (size_t)t * UW + U_PG + cgp * 8);
                    float y[8];
                    y[0] = (s[0] * ic - bf_lo(xs.x)) * bf_lo(gt.x); y[1] = (s[1] * ic - bf_hi(xs.x)) * bf_hi(gt.x);
                    y[2] = (s[2] * ic - bf_lo(xs.y)) * bf_lo(gt.y); y[3] = (s[3] * ic - bf_hi(xs.y)) * bf_hi(gt.y);
                    y[4] = (s[4] * ic - bf_lo(xs.z)) * bf_lo(gt.z); y[5] = (s[5] * ic - bf_hi(xs.z)) * bf_hi(gt.z);
                    y[6] = (s[6] * ic - bf_lo(xs.w)) * bf_lo(gt.w); y[7] = (s[7] * ic - bf_hi(xs.w)) * bf_hi(gt.w);
                    u32x4 o; o.x = cvt_pk_bf16(y[0], y[1]); o.y = cvt_pk_bf16(y[2], y[3]); o.z = cvt_pk_bf16(y[4], y[5]); o.w = cvt_pk_bf16(y[6], y[7]);
                    *(u32x4*)(MIX + (size_t)t * DM + 256 + cgp * 8) = o;
                }
                { bf16_t* rowl = (bf16_t*)(lds + wave * 16896);
                  for (int r = gw; r < 4096; r += NGW) { bf16_t* xr = XT + (size_t)r * KD;
                      { u32x4 tmpv[17];
#pragma unroll
                        for (int it = 0; it < 17; ++it) { const int c = lane + 64 * it; if (c < KD / 8) tmpv[it] = *(const u32x4*)(xr + c * 8); }
#pragma unroll
                        for (int it = 0; it < 17; ++it) { const int c = lane + 64 * it; if (c < KD / 8) *(u32x4*)(rowl + c * 8) = tmpv[it]; } }
                      asm volatile("s_waitcnt vmcnt(0) lgkmcnt(0)" ::: "memory");
                      for (int c = lane; c < KF / 8; c += 64) { const int c0 = c * 8, hs = c0 >= LF, l0 = c0 - hs * LF; const bf16_t* hb = rowl + hs * LP; float v[8];
#pragma unroll
                          for (int e = 0; e < 8; ++e) { const int l = l0 + e; float x = 0.f;
                              if (l <= LH) { x = bf1(hb[l]); if (l > 0 && l < LH) { const float y = bf1(hb[L - l]); x = hs ? x - y : x + y; } else if (hs) x = 0.f; }
                              v[e] = x; }
                          u32x4 o; o.x = cvt_pk_bf16(v[0], v[1]); o.y = cvt_pk_bf16(v[2], v[3]); o.z = cvt_pk_bf16(v[4], v[5]); o.w = cvt_pk_bf16(v[6], v[7]);
                          *(u32x4*)(xr + c0) = o; }
                      asm volatile("s_waitcnt vmcnt(0) lgkmcnt(0)" ::: "memory"); } }
            } else if (kind == 4 && PHM(4)) {
                float* PART = (float*)(ws + WS_PART);
                for (int i = 0;; ++i) { const int uidx = i * G + vcu; if (uidx >= 1024 + 256) break;
                    if (uidx < 1024) { const int bh = uidx >> 4, qb = uidx & 15; att::attn_unit(bh >> 2, bh & 3, qb, Qb, KVb, U, MIX, (char*)lds, ldsl, 0, att::NT, nullptr, wave_s); }
                    else { const int v = uidx - 1024, bh = v >> 2, q = v & 3;
                        const int tb = q < 2 ? 17 * q : 34 + 16 * (q - 2), te = q < 2 ? tb + 17 : (q == 2 ? tb + 16 : att::NT);
                        att::attn_unit(bh >> 2, bh & 3, 16, Qb, KVb, U, MIX, (char*)lds, ldsl, tb, te, PART + (size_t)v * PART_STRIDE, wave_s); } }
                __syncthreads();
            }
        }
    }
        asm volatile("s_waitcnt vmcnt(0) lgkmcnt(0)" ::: "memory");
        if (ph + 1 < a.ph_hi) {
            if (ph == a.ph_lo) grid.sync();
            else xcd_barrier((unsigned*)(ws + WS_BAR), (volatile LAS unsigned*)(ldsl + 135168), tid == 0);
        }
    }
}


#ifndef N_LAUNCH_SPLIT
#define N_LAUNCH_SPLIT 0
#endif
extern "C" void kernel_launch(void* const* d_in, const int* in_sizes, int n_in, void* d_out, int out_size, void* d_ws, size_t ws_size, hipStream_t stream) {
    static int grid = 0;
    if (grid == 0) {
        if (n_in != 13 || in_sizes[0] != NB * SEQ * DM || out_size != NB * SEQ * DM || ws_size < WS_END + 256) {
            fprintf(stderr, "kernel_launch: shape/workspace mismatch: n_in %d in0 %d out %d ws %zu (need %zu)\n", n_in, n_in > 0 ? in_sizes[0] : -1, out_size, ws_size, (size_t)WS_END); grid = -1; return; }
        int dev = 0, cus = 0, per_cu = 0;
        hipGetDevice(&dev); hipDeviceGetAttribute(&cus, hipDeviceAttributeMultiprocessorCount, dev);
        if (hipFuncSetAttribute((const void*)hymba_fwd, hipFuncAttributeMaxDynamicSharedMemorySize, LDS_BYTES) != hipSuccess) { fprintf(stderr, "kernel_launch: hipFuncSetAttribute failed\n"); grid = -1; return; }
        if (hipOccupancyMaxActiveBlocksPerMultiprocessor(&per_cu, (const void*)hymba_fwd, 512, LDS_BYTES) != hipSuccess || per_cu < 1) { fprintf(stderr, "kernel_launch: occupancy query gave %d\n", per_cu); per_cu = 1; }
        (void)hipGetLastError();
        grid = cus;
    }
    if (grid < 0) return;
    Args a{};
    a.x = (const float*)d_in[0]; a.meta = (const float*)d_in[1]; a.norm_w = (const float*)d_in[2]; a.w_in = (const float*)d_in[3]; a.fourier_w = (const float*)d_in[4];
    a.pool_w = (const float*)d_in[5]; a.pool_scale = (const float*)d_in[6]; a.q_norm_w = (const float*)d_in[7]; a.w_uq = (const float*)d_in[8]; a.kv_norm_w = (const float*)d_in[9];
    a.w_ukv = (const float*)d_in[10]; a.w_out = (const float*)d_in[11]; a.final_norm_w = (const float*)d_in[12];
    a.out = (float*)d_out; a.ws = (unsigned char*)d_ws;
    constexpr int NPH = 2 + 6 * DEPTH;
#if N_LAUNCH_SPLIT
    for (int p = 0; p < NPH; ++p) { a.ph_lo = p; a.ph_hi = p + 1; void* args[] = {&a};
        hipError_t e = hipLaunchCooperativeKernel((void*)hymba_fwd, dim3(grid), dim3(512), args, LDS_BYTES, stream);
        if (e != hipSuccess) { fprintf(stderr, "cooperative launch failed: %s\n", hipGetErrorString(e)); break; } }
#else
    (void)hipMemsetAsync((char*)d_ws + WS_BAR, 0, (size_t)XCD_BAR_WORDS * 4, stream);
    a.ph_lo = 0; a.ph_hi = NPH; void* args[] = {&a};
    hipError_t e = hipLaunchCooperativeKernel((void*)hymba_fwd, dim3(grid), dim3(512), args, LDS_BYTES, stream);
    if (e != hipSuccess) fprintf(stderr, "cooperative launch failed: %s (grid %d)\n", hipGetErrorString(e), grid);
#endif
}
```

```cpp
#include <hip/hip_runtime.h>
#include <hip/hip_cooperative_groups.h>
#include <cstdio>
#include <cstdint>
namespace cg = cooperative_groups;

#define LAS __attribute__((address_space(3)))
typedef unsigned short bf16_t;
typedef short bf16x8 __attribute__((ext_vector_type(8)));
typedef short s16x4 __attribute__((ext_vector_type(4)));
typedef float f32x4 __attribute__((ext_vector_type(4)));
typedef float f32x8 __attribute__((ext_vector_type(8)));
typedef float f32x16 __attribute__((ext_vector_type(16)));
typedef unsigned u32x4 __attribute__((ext_vector_type(4)));
typedef unsigned u32x2 __attribute__((ext_vector_type(2)));

constexpr int DM = 1024, NB = 16, SEQ = 4096, NMETA = 16, L = SEQ + NMETA, MTOK = NB * L, DEPTH = 4;
constexpr int DIN = 2240, UW = 2048;
constexpr int LP = 4224, KD = 2 * LP;
constexpr int LH = L / 2, LF = 2176, KF = 2 * LF;
constexpr int QW = 768, KVW = 1024;
constexpr float NORM_EPS = 1e-6f;
constexpr int U_CQ = 0, U_KR = 384, U_CKV = 512, U_FG = 768, U_PP = 1024, U_PG = 1280, U_AG = 1536;

constexpr size_t al256(size_t x) { return (x + 255) / 256 * 256; }
constexpr size_t WS_H = 0;
constexpr size_t WS_RH = WS_H + al256((size_t)MTOK * DM * 2);
constexpr size_t WS_HN = WS_RH + al256((size_t)MTOK * 4);
constexpr size_t WS_U = WS_HN + al256((size_t)MTOK * DM * 2);
constexpr size_t WS_XT = WS_U + al256((size_t)MTOK * UW * 2);
constexpr size_t WS_DFT = WS_XT + al256((size_t)4096 * KD * 2);
constexpr size_t WS_Q = WS_DFT + al256((size_t)L * KF * 2);
constexpr size_t WS_KV = WS_Q + al256((size_t)MTOK * QW * 2);
constexpr size_t WS_WN = WS_KV + al256((size_t)MTOK * KVW * 2);
constexpr size_t WS_WF = WS_WN + al256((size_t)UW * DM * 2);
constexpr size_t WS_WQ = WS_WF + al256((size_t)512 * DM * 2);
constexpr size_t WS_WKV = WS_WQ + al256((size_t)768 * 384 * 2);
constexpr size_t WS_WO = WS_WKV + al256((size_t)1024 * 256 * 2);
constexpr size_t WS_RQ = WS_WO + al256((size_t)1024 * 1024 * 2);
constexpr size_t WS_RKV = WS_RQ + al256((size_t)MTOK * 4);
constexpr size_t WS_COS = WS_RKV + al256((size_t)MTOK * 4);
constexpr size_t WS_SIN = WS_COS + al256((size_t)L * 32 * 4);
constexpr size_t WS_CWF = WS_SIN + al256((size_t)L * 32 * 4);
constexpr size_t WS_SWF = WS_CWF + al256((size_t)DEPTH * 4 * 64 * 64 * 4);
constexpr size_t WS_PART = WS_SWF + al256((size_t)DEPTH * 4 * 64 * 64 * 4);
constexpr int PART_STRIDE = 16 * 128 + 32;
constexpr size_t WS_BAR = WS_PART + al256((size_t)256 * PART_STRIDE * 4);
constexpr size_t WS_END = WS_BAR + al256((size_t)3456 * 4);

constexpr int LDS_BYTES = 131072 + 4096 + 64;

__device__ __forceinline__ unsigned cvt_pk_bf16(float lo, float hi) { unsigned r; asm volatile("v_cvt_pk_bf16_f32 %0, %1, %2" : "=v"(r) : "v"(lo), "v"(hi)); return r; }
__device__ __forceinline__ int opaque_tid_w(int wave_s) { int t; asm volatile("v_mbcnt_lo_u32_b32 %0, -1, 0\n\tv_mbcnt_hi_u32_b32 %0, -1, %0" : "=&v"(t)); return (wave_s << 6) | t; }
__device__ __forceinline__ float opaque_zero() { float z; asm volatile("v_mov_b32 %0, 0" : "=v"(z)); return z; }
__device__ __forceinline__ float bf_lo(unsigned w) { return __uint_as_float(w << 16); }
__device__ __forceinline__ float bf_hi(unsigned w) { return __uint_as_float(w & 0xffff0000u); }
__device__ __forceinline__ float bf1(bf16_t x) { return __uint_as_float((unsigned)x << 16); }
__device__ __forceinline__ float wave_sum_l(float v, int lane) {
#pragma unroll
    for (int o = 1; o < 64; o <<= 1) v += __uint_as_float((unsigned)__builtin_amdgcn_ds_bpermute((lane ^ o) << 2, (int)__float_as_uint(v)));
    return v;
}
#define wave_sum(v) wave_sum_l((v), lane)
__device__ __forceinline__ float silu_f(float x) { return x * __builtin_amdgcn_rcpf(1.f + __expf(-x)); }
__device__ __forceinline__ u32x4 pack8(f32x4 a, f32x4 b) { u32x4 w; w.x = cvt_pk_bf16(a[0], a[1]); w.y = cvt_pk_bf16(a[2], a[3]); w.z = cvt_pk_bf16(b[0], b[1]); w.w = cvt_pk_bf16(b[2], b[3]); return w; }
__device__ __forceinline__ int rope_src(int jj) { const int g = jj >> 3, e = jj & 7; return e < 4 ? 4 * g + e : 28 + 4 * g + e; }

namespace pg8 {
constexpr int BM = 256, BK = 64, HALF = 128, HTB = HALF * BK * 2, NXCD = 8, WGM = 8;
__host__ __device__ __forceinline__ int lds_byte(int r, int c) { const int st = (r >> 4) * 2 + (c >> 5), rr = r & 15, cc = c & 31, ob = rr * 64 + cc * 2; return st * 1024 + (ob ^ (((ob >> 9) & 1) << 5)); }
__host__ __device__ __forceinline__ void stage_rc(int b, int& R, int& C) { const int st = b / 1024, sb = b % 1024, swz = sb ^ (((sb >> 9) & 1) << 5); R = (st >> 1) * 16 + swz / 64; C = (st & 1) * 32 + (swz % 64) / 2; }
__host__ __device__ __forceinline__ int perm32(int rho) { const int n = rho >> 4, i = rho & 15; return 8 * (i >> 2) + 4 * n + (i & 3); }
struct Unit { int pm, pn; };
struct Gemm { const bf16_t* A; const bf16_t* Bt; int M, N, K, lda, ldb; };
struct StaticOrder {
    int nM, nN, nwg, G, c;
    __device__ void init(int M, int N, int G_, int c_) { nM = M / BM; nN = N / BM; nwg = nM * nN; G = G_; c = c_; }
    __device__ bool next(int i, Unit& u) const {
        const long Lx = (long)i * G + c; if (Lx >= nwg) return false;
        int wgid = (int)Lx; { const int q = nwg / NXCD, r = nwg % NXCD, xcd = wgid % NXCD, off = wgid / NXCD; wgid = (xcd < r ? xcd * (q + 1) : r * (q + 1) + (xcd - r) * q) + off; }
        const int nig = WGM * nN, gid = wgid / nig, fm = gid * WGM, gsz = (nM - fm) < WGM ? (nM - fm) : WGM;
        u.pm = fm + ((wgid % nig) % gsz); u.pn = (wgid % nig) / gsz; return true;
    }
};
template <class Epi>
__device__ __forceinline__ void gemm_phase(LAS unsigned char* lds, const Gemm g, const StaticOrder& S, const Epi& E, int wave_s) {
    const int tid = opaque_tid_w(wave_s), wid = __builtin_amdgcn_readfirstlane(tid >> 6), lane = tid & 63, wr = wid >> 2, wc = wid & 3, fr = lane & 15, fq = lane >> 4;
    const int K = g.K, nt = K / BK;
    unsigned voffA[2], voffB[2];
#pragma unroll
    for (int i = 0; i < 2; ++i) { int R, C; stage_rc(tid * 16 + i * 8192, R, C); const int Rb = (R & ~31) + perm32(R & 31);
        voffA[i] = (unsigned)(R * g.lda + C) * 2u; voffB[i] = (unsigned)(Rb * g.ldb + C) * 2u; }
    const size_t kstep = (size_t)(BK * 2);
    const size_t hstepA = (size_t)HALF * g.lda * 2, hstepB = (size_t)HALF * g.ldb * 2;
    const size_t tstepA = 2 * hstepA, tstepB = 2 * hstepB;
    const unsigned ldsw = (unsigned)wid * 1024u;
    const int aoff = lds_byte(wr * 64 + fr, fq * 8), boff = lds_byte(wc * 32 + fr, fq * 8);
#define PG8_SA(b, h) (((b) * 2 + (h)) * HTB)
#define PG8_SB(b, h) ((4 + (b) * 2 + (h)) * HTB)
#define PG8_STAGE(bufoff, gbase, voff) do { _Pragma("unroll") for (int _i = 0; _i < 2; ++_i) \
        __builtin_amdgcn_global_load_lds((const unsigned*)((const char*)(gbase) + (voff)[_i]), (LAS unsigned*)(lds + (bufoff) + ldsw + _i * 8192), 16, 0, 0); } while (0)
#define PG8_LDA(dst, b, h) do { _Pragma("unroll") for (int m = 0; m < 4; ++m) _Pragma("unroll") for (int k = 0; k < 2; ++k) dst[m][k] = *(const LAS bf16x8*)(lds + PG8_SA(b, h) + aoff + m * 2048 + k * 1024); } while (0)
#define PG8_LDB(dst, b, h) do { _Pragma("unroll") for (int n = 0; n < 2; ++n) _Pragma("unroll") for (int k = 0; k < 2; ++k) dst[n][k] = *(const LAS bf16x8*)(lds + PG8_SB(b, h) + boff + n * 2048 + k * 1024); } while (0)
#define PG8_MMA(ai, bj, At, Bt) do { __builtin_amdgcn_s_setprio(1); _Pragma("unroll") for (int m = 0; m < 4; ++m) _Pragma("unroll") for (int n = 0; n < 2; ++n) _Pragma("unroll") for (int k = 0; k < 2; ++k) \
        acc[ai][bj][m][n] = __builtin_amdgcn_mfma_f32_16x16x32_bf16(Bt[n][k], At[m][k], acc[ai][bj][m][n], 0, 0, 0); __builtin_amdgcn_s_setprio(0); } while (0)
#define PG8_WAIT_V(n) asm volatile("s_waitcnt vmcnt(" #n ")" ::: "memory")
#define PG8_WAIT_L(n) asm volatile("s_waitcnt lgkmcnt(" #n ")" ::: "memory")
#define PG8_BAR __builtin_amdgcn_s_barrier()
#define PG8_SCHED __builtin_amdgcn_sched_barrier(0)
    Unit cur, nxt; int ui = 0;
    if (!S.next(0, cur)) return;
    f32x4 acc[2][2][4][2];
#pragma unroll
    for (int a = 0; a < 2; ++a)
#pragma unroll
        for (int b = 0; b < 2; ++b)
#pragma unroll
            for (int m = 0; m < 4; ++m)
#pragma unroll
                for (int n = 0; n < 2; ++n) { float z; asm volatile("v_mov_b32 %0, 0" : "=v"(z)); acc[a][b][m][n] = (f32x4){z, z, z, z}; }
    bf16x8 At[4][2], B0[2][2], B1[2][2];
    const char* cA = (const char*)g.A + (size_t)cur.pm * tstepA; const char* cB = (const char*)g.Bt + (size_t)cur.pn * tstepB;
    PG8_STAGE(PG8_SB(0, 0), cB, voffB); PG8_STAGE(PG8_SB(0, 1), cB + hstepB, voffB); PG8_STAGE(PG8_SA(0, 0), cA, voffA); PG8_STAGE(PG8_SA(0, 1), cA + hstepA, voffA);
    if (wr == 1) PG8_BAR;
    PG8_WAIT_V(2); PG8_BAR;
    PG8_STAGE(PG8_SB(1, 0), cB + kstep, voffB); PG8_STAGE(PG8_SA(1, 0), cA + kstep, voffA); PG8_STAGE(PG8_SB(1, 1), cB + hstepB + kstep, voffB);
    PG8_WAIT_V(6); PG8_BAR;
    for (;;) {
        const bool has_next = S.next(ui + 1, nxt);
        const char* nA = has_next ? (const char*)g.A + (size_t)nxt.pm * tstepA : cA; const char* nB = has_next ? (const char*)g.Bt + (size_t)nxt.pn * tstepB : cB;
#pragma unroll 1
        for (int t = 0; t < nt; t += 2) {
            const bool last = (t == nt - 2);
            const char* a1 = cA + (size_t)(t + 1) * kstep;
            const char* a2 = last ? nA : cA + (size_t)(t + 2) * kstep; const char* b2 = last ? nB : cB + (size_t)(t + 2) * kstep;
            const char* a3 = a2 + kstep; const char* b3 = b2 + kstep;
            PG8_LDB(B0, 0, 0); PG8_LDB(B1, 0, 1); PG8_SCHED; PG8_LDA(At, 0, 0); PG8_STAGE(PG8_SA(1, 1), a1 + hstepA, voffA);
            PG8_WAIT_V(8); PG8_WAIT_L(0); PG8_BAR; PG8_MMA(0, 0, At, B0); PG8_MMA(0, 1, At, B1); PG8_BAR; PG8_SCHED;
            PG8_LDA(At, 0, 1); PG8_STAGE(PG8_SB(0, 0), b2, voffB); PG8_STAGE(PG8_SB(0, 1), b2 + hstepB, voffB); PG8_STAGE(PG8_SA(0, 0), a2, voffA);
            PG8_WAIT_V(8); PG8_WAIT_L(0); PG8_BAR; PG8_MMA(1, 0, At, B0); PG8_MMA(1, 1, At, B1); PG8_BAR; PG8_SCHED;
            PG8_LDB(B0, 1, 0); PG8_LDB(B1, 1, 1); PG8_SCHED; PG8_LDA(At, 1, 0); PG8_STAGE(PG8_SA(0, 1), a2 + hstepA, voffA);
            PG8_WAIT_V(8); PG8_WAIT_L(0); PG8_BAR; PG8_MMA(0, 0, At, B0); PG8_MMA(0, 1, At, B1); PG8_BAR; PG8_SCHED;
            PG8_LDA(At, 1, 1); PG8_STAGE(PG8_SB(1, 0), b3, voffB); PG8_STAGE(PG8_SB(1, 1), b3 + hstepB, voffB); PG8_STAGE(PG8_SA(1, 0), a3, voffA);
            PG8_WAIT_V(8); PG8_WAIT_L(0); PG8_BAR; PG8_MMA(1, 0, At, B0); PG8_MMA(1, 1, At, B1); PG8_BAR; PG8_SCHED;
        }
        if (wr == 0) PG8_BAR;
        E(acc, cur, wr, wc, fr, fq);
        if (!has_next) break;
#pragma unroll
        for (int a = 0; a < 2; ++a)
#pragma unroll
            for (int b = 0; b < 2; ++b)
#pragma unroll
                for (int m = 0; m < 4; ++m)
#pragma unroll
                    for (int n = 0; n < 2; ++n) { float z; asm volatile("v_mov_b32 %0, 0" : "=v"(z)); acc[a][b][m][n] = (f32x4){z, z, z, z}; }
        cur = nxt; cA = nA; cB = nB; ++ui;
        if (wr == 1) PG8_BAR;
    }
    PG8_WAIT_V(0);
    PG8_BAR;
#undef PG8_SA
#undef PG8_SB
#undef PG8_STAGE
#undef PG8_LDA
#undef PG8_LDB
#undef PG8_MMA
#undef PG8_WAIT_V
#undef PG8_WAIT_L
#undef PG8_BAR
#undef PG8_SCHED
}
}
using pg8::Unit;
typedef const f32x4 (&AccRef)[2][2][4][2];

__device__ __forceinline__ void rope8(f32x4& v0, f32x4& v1, const float* cs, const float* sn, int pos, int g) {
    const f32x4 c = *(const f32x4*)(cs + pos * 32 + 4 * g), s = *(const f32x4*)(sn + pos * 32 + 4 * g);
    const f32x4 a = v0 * c - v1 * s, b = v1 * c + v0 * s; v0 = a; v1 = b;
}
struct EpiU {
    bf16_t* U; const float* cs; const float* sn; const float* rh;
    __device__ __forceinline__ void operator()(AccRef acc, const Unit& u, int wr, int wc, int fr, int fq) const {
        const int row0 = u.pm * 256 + wr * 64 + fr;
        float rsv[2][4];
#pragma unroll
        for (int ai = 0; ai < 2; ++ai)
#pragma unroll
            for (int m = 0; m < 4; ++m) rsv[ai][m] = rh[row0 + ai * 128 + m * 16];
#pragma unroll
        for (int bj = 0; bj < 2; ++bj) {
            const int blk = u.pn * 256 + bj * 128 + wc * 32, col0 = blk + 8 * fq;
            const bool dosilu = blk >= U_FG && !(blk >= U_PP && blk < U_PG);
            const bool dorope = blk >= U_KR && blk < U_KR + 64;
#pragma unroll
            for (int ai = 0; ai < 2; ++ai)
#pragma unroll
                for (int m = 0; m < 4; ++m) {
                    const int row = row0 + ai * 128 + m * 16;
                    f32x4 v0 = acc[ai][bj][m][0] * rsv[ai][m], v1 = acc[ai][bj][m][1] * rsv[ai][m];
                    if (dorope) rope8(v0, v1, cs, sn, row % L, (col0 - U_KR) >> 3);
                    if (dosilu) {
#pragma unroll
                        for (int e = 0; e < 4; ++e) { v0[e] = silu_f(v0[e]); v1[e] = silu_f(v1[e]); }
                    }
                    *(u32x4*)(U + (size_t)row * UW + col0) = pack8(v0, v1);
                    __builtin_amdgcn_sched_barrier(0);
                }
        }
    }
};
struct EpiXT {
    bf16_t* XT; const float* rh;
    __device__ __forceinline__ void operator()(AccRef acc, const Unit& u, int wr, int wc, int fr, int fq) const {
        const int row0 = u.pm * 256 + wr * 64 + fr;
#pragma unroll
        for (int bj = 0; bj < 2; ++bj) {
            const int t0 = u.pn * 256 + bj * 128 + wc * 32 + 8 * fq, b = t0 / L, l = t0 - b * L;
            const f32x4 ra = *(const f32x4*)(rh + t0), rb = *(const f32x4*)(rh + t0 + 4);
#pragma unroll
            for (int ai = 0; ai < 2; ++ai)
#pragma unroll
                for (int m = 0; m < 4; ++m) {
                    const int np = row0 + ai * 128 + m * 16;
                    *(u32x4*)(XT + (size_t)(b * 256 + (np & 255)) * KD + (np >> 8) * LP + l) = pack8(acc[ai][bj][m][0] * ra, acc[ai][bj][m][1] * rb);
                }
        }
    }
};
struct EpiDFT {
    bf16_t* MIX; const bf16_t* U;
    __device__ __forceinline__ void operator()(AccRef acc, const Unit& u, int wr, int wc, int fr, int fq) const {
        const int row0 = u.pm * 256 + wr * 64 + fr, b = u.pn;
#pragma unroll
        for (int ai = 0; ai < 2; ++ai) {
            u32x4 gt[4][2];
#pragma unroll
            for (int m = 0; m < 4; ++m)
#pragma unroll
                for (int bj = 0; bj < 2; ++bj) gt[m][bj] = *(const u32x4*)(U + ((size_t)b * L + row0 + ai * 128 + m * 16) * UW + U_FG + bj * 128 + wc * 32 + 8 * fq);
#pragma unroll
            for (int m = 0; m < 4; ++m)
#pragma unroll
                for (int bj = 0; bj < 2; ++bj) { const size_t tok = (size_t)b * L + row0 + ai * 128 + m * 16; const int n = bj * 128 + wc * 32 + 8 * fq; const u32x4 g = gt[m][bj];
                    f32x4 v0 = acc[ai][bj][m][0], v1 = acc[ai][bj][m][1];
                    v0[0] *= bf_lo(g.x); v0[1] *= bf_hi(g.x); v0[2] *= bf_lo(g.y); v0[3] *= bf_hi(g.y);
                    v1[0] *= bf_lo(g.z); v1[1] *= bf_hi(g.z); v1[2] *= bf_lo(g.w); v1[3] *= bf_hi(g.w);
                    *(u32x4*)(MIX + tok * DM + n) = pack8(v0, v1); }
            __builtin_amdgcn_sched_barrier(0);
        }
    }
};
struct EpiQ {
    bf16_t* Q; const float* rq; const float* cs; const float* sn;
    __device__ __forceinline__ void operator()(AccRef acc, const Unit& u, int wr, int wc, int fr, int fq) const {
        const int row0 = u.pm * 256 + wr * 64 + fr;
        float rsv[2][4];
#pragma unroll
        for (int ai = 0; ai < 2; ++ai)
#pragma unroll
            for (int m = 0; m < 4; ++m) rsv[ai][m] = rq[row0 + ai * 128 + m * 16];
#pragma unroll
        for (int bj = 0; bj < 2; ++bj) {
            const int blk = u.pn * 256 + bj * 128 + wc * 32, col0 = blk + 8 * fq, w = blk % 192;
            const bool dorope = w >= 128;
#pragma unroll
            for (int ai = 0; ai < 2; ++ai)
#pragma unroll
                for (int m = 0; m < 4; ++m) {
                    const int row = row0 + ai * 128 + m * 16; const float rs = rsv[ai][m];
                    f32x4 v0 = acc[ai][bj][m][0] * rs, v1 = acc[ai][bj][m][1] * rs;
                    if (dorope) rope8(v0, v1, cs, sn, row % L, (w - 128 + 8 * fq) >> 3);
                    *(u32x4*)(Q + (size_t)row * QW + col0) = pack8(v0, v1);
                    if (m == 3) __builtin_amdgcn_sched_barrier(0);
                }
        }
    }
};
struct EpiKV {
    bf16_t* KV; const float* rkv;
    __device__ __forceinline__ void operator()(AccRef acc, const Unit& u, int wr, int wc, int fr, int fq) const {
        const int row0 = u.pm * 256 + wr * 64 + fr;
        float rsv[2][4];
#pragma unroll
        for (int ai = 0; ai < 2; ++ai)
#pragma unroll
            for (int m = 0; m < 4; ++m) rsv[ai][m] = rkv[row0 + ai * 128 + m * 16];
#pragma unroll
        for (int ai = 0; ai < 2; ++ai)
#pragma unroll
            for (int m = 0; m < 4; ++m) {
                const int row = row0 + ai * 128 + m * 16; const float rs = rsv[ai][m];
#pragma unroll
                for (int bj = 0; bj < 2; ++bj) {
                    const int col0 = u.pn * 256 + bj * 128 + wc * 32 + 8 * fq;
                    *(u32x4*)(KV + (size_t)row * KVW + col0) = pack8(acc[ai][bj][m][0] * rs, acc[ai][bj][m][1] * rs);
                }
            }
    }
};
struct EpiOut {
    bf16_t* H;
    __device__ __forceinline__ void operator()(AccRef acc, const Unit& u, int wr, int wc, int fr, int fq) const {
        const int row0 = u.pm * 256 + wr * 64 + fr;
#pragma unroll
        for (int ai = 0; ai < 2; ++ai) {
            u32x4 hv[4][2];
#pragma unroll
            for (int m = 0; m < 4; ++m)
#pragma unroll
                for (int bj = 0; bj < 2; ++bj) hv[m][bj] = *(const u32x4*)(H + (size_t)(row0 + ai * 128 + m * 16) * DM + u.pn * 256 + bj * 128 + wc * 32 + 8 * fq);
#pragma unroll
            for (int m = 0; m < 4; ++m)
#pragma unroll
                for (int bj = 0; bj < 2; ++bj) { const u32x4 g = hv[m][bj]; f32x4 v0 = acc[ai][bj][m][0], v1 = acc[ai][bj][m][1];
                    v0[0] += bf_lo(g.x); v0[1] += bf_hi(g.x); v0[2] += bf_lo(g.y); v0[3] += bf_hi(g.y);
                    v1[0] += bf_lo(g.z); v1[1] += bf_hi(g.z); v1[2] += bf_lo(g.w); v1[3] += bf_hi(g.w);
                    *(u32x4*)(H + (size_t)(row0 + ai * 128 + m * 16) * DM + u.pn * 256 + bj * 128 + wc * 32 + 8 * fq) = pack8(v0, v1); }
            __builtin_amdgcn_sched_barrier(0);
        }
    }
};
struct EpiAll {
    int kind; unsigned char* ws;
    __device__ __forceinline__ void operator()(AccRef acc, const Unit& u, int wr, int wc, int fr, int fq) const {
        asm volatile("" : "+v"(fr), "+v"(fq));
        bf16_t* U = (bf16_t*)(ws + WS_U); const float* COS = (const float*)(ws + WS_COS); const float* SIN = (const float*)(ws + WS_SIN);
        switch (kind) {
            case 0: { EpiU E{U, COS, SIN, (const float*)(ws + WS_RH)}; E(acc, u, wr, wc, fr, fq); break; }
            case 1: { EpiXT E{(bf16_t*)(ws + WS_XT), (const float*)(ws + WS_RH)}; E(acc, u, wr, wc, fr, fq); break; }
            case 2: { EpiDFT E{(bf16_t*)(ws + WS_HN), U}; E(acc, u, wr, wc, fr, fq); break; }
            case 3: { EpiQ E{(bf16_t*)(ws + WS_Q), (const float*)(ws + WS_RQ), COS, SIN}; E(acc, u, wr, wc, fr, fq); break; }
            case 4: { EpiKV E{(bf16_t*)(ws + WS_KV), (const float*)(ws + WS_RKV)}; E(acc, u, wr, wc, fr, fq); break; }
            default: { EpiOut E{(bf16_t*)(ws + WS_H)}; E(acc, u, wr, wc, fr, fq); break; }
        }
    }
};

namespace att {
constexpr int NW = 8, QBLK = 32, KVBLK = 64, NT = 65;
constexpr float SCALE = 0.07216878364870322f, THR = 8.f;
constexpr int SHM_V = 16384, SHM_K = 16384, SHM_R = 8192;
constexpr int OFF_V = 0, OFF_K = 2 * SHM_V, OFF_R = OFF_K + 2 * SHM_K, OFF_WS = OFF_R + 2 * SHM_R, OFF_QR = OFF_WS + 2048;
#define KSWZ(row, colB) ((row) * 256 + ((colB) ^ (((row) & 15) << 4)))
#define RSWZ(row, colB) ((row) * 128 + ((colB) ^ ((((row) >> 1) & 7) << 4)))
#define SBAR() __builtin_amdgcn_sched_barrier(0)
__device__ __forceinline__ int crow(int r, int hi) { return (r & 3) + 8 * (r >> 2) + 4 * hi; }
__device__ __forceinline__ void partialSM(f32x16& p0, f32x16& p1, float& m_reg, float& mn, float& alpha) {
    constexpr float C = SCALE * 1.4426950408889634f;
    float pmax = p0[0];
#pragma unroll
    for (int r = 1; r < 16; ++r) pmax = fmaxf(pmax, p0[r]);
#pragma unroll
    for (int r = 0; r < 16; ++r) pmax = fmaxf(pmax, p1[r]);
    { auto rr = __builtin_amdgcn_permlane32_swap(__float_as_uint(pmax), __float_as_uint(pmax), false, false);
      pmax = fmaxf(__uint_as_float(rr[0]), __uint_as_float(rr[1])); }
    if (__builtin_expect(__all(pmax - m_reg <= THR / SCALE), 1)) { mn = m_reg; alpha = 1.f; }
    else { mn = fmaxf(m_reg, pmax); alpha = __builtin_amdgcn_exp2f((m_reg - mn) * C); m_reg = mn; }
    const float mnC = -mn * C;
#pragma unroll
    for (int r = 0; r < 16; ++r) p0[r] = fmaf(p0[r], C, mnC);
#pragma unroll
    for (int r = 0; r < 16; ++r) p1[r] = fmaf(p1[r], C, mnC);
#pragma unroll
    for (int r = 0; r < 16; ++r) p0[r] = __builtin_amdgcn_exp2f(p0[r]);
}
__device__ __forceinline__ void finishSM(f32x16& p0, f32x16& p1, float alpha, float& l_reg, bf16x8& pa0, bf16x8& pa1, bf16x8& pa2, bf16x8& pa3) {
#pragma unroll
    for (int r = 0; r < 16; ++r) p1[r] = __builtin_amdgcn_exp2f(p1[r]);
    float ps = 0;
#pragma unroll
    for (int r = 0; r < 16; ++r) ps += p0[r];
#pragma unroll
    for (int r = 0; r < 16; ++r) ps += p1[r];
    { auto rr = __builtin_amdgcn_permlane32_swap(__float_as_uint(ps), __float_as_uint(ps), false, false);
      ps = __uint_as_float(rr[0]) + __uint_as_float(rr[1]); }
    l_reg = l_reg * alpha + ps;
#define PK4(P, BASE, OUT) do { unsigned a0 = cvt_pk_bf16(P[BASE + 0], P[BASE + 1]), a1 = cvt_pk_bf16(P[BASE + 2], P[BASE + 3]);   \
    unsigned b0 = cvt_pk_bf16(P[BASE + 4], P[BASE + 5]), b1 = cvt_pk_bf16(P[BASE + 6], P[BASE + 7]);                              \
    auto r0 = __builtin_amdgcn_permlane32_swap(a0, b0, false, false); auto r1 = __builtin_amdgcn_permlane32_swap(a1, b1, false, false); \
    u32x4 w = {r0[0], r1[0], r0[1], r1[1]}; OUT = *reinterpret_cast<bf16x8*>(&w); } while (0)
    PK4(p0, 0, pa0); PK4(p0, 8, pa1); PK4(p1, 0, pa2); PK4(p1, 8, pa3);
#undef PK4
}
__device__ __forceinline__ void qkt(f32x16& p0, f32x16& p1, const char* Ks, const char* Rs, const bf16x8* qr, const char* qrl, int r32, int hi) {
    p0 = f32x16{}; p1 = f32x16{};
#pragma unroll
    for (int d0 = 0; d0 < 8; ++d0) { const int cb = (d0 * 16 + hi * 8) * 2;
        bf16x8 b0 = *reinterpret_cast<const bf16x8*>(Ks + KSWZ(r32, cb));
        bf16x8 b1 = *reinterpret_cast<const bf16x8*>(Ks + KSWZ(32 + r32, cb));
        p0 = __builtin_amdgcn_mfma_f32_32x32x16_bf16(b0, qr[d0], p0, 0, 0, 0);
        p1 = __builtin_amdgcn_mfma_f32_32x32x16_bf16(b1, qr[d0], p1, 0, 0, 0); }
#pragma unroll
    for (int d0 = 0; d0 < 4; ++d0) { const int cb = (d0 * 16 + hi * 8) * 2;
        bf16x8 b0 = *reinterpret_cast<const bf16x8*>(Rs + RSWZ(r32, cb));
        bf16x8 b1 = *reinterpret_cast<const bf16x8*>(Rs + RSWZ(32 + r32, cb));
        p0 = __builtin_amdgcn_mfma_f32_32x32x16_bf16(b0, qr[8 + d0], p0, 0, 0, 0);
        p1 = __builtin_amdgcn_mfma_f32_32x32x16_bf16(b1, qr[8 + d0], p1, 0, 0, 0); }
}
__device__ __forceinline__ void kmask(f32x16& p0, f32x16& p1, int k0, int hi) {
#pragma unroll
    for (int r = 0; r < 16; ++r) { const int kv = k0 + crow(r, hi); if (kv >= L) p0[r] = -1e30f; if (kv + 32 >= L) p1[r] = -1e30f; }
}
__device__ __forceinline__ int v_st(int k, int c) { const int kk = (k & ~0xC) | ((k & 4) << 1) | ((k & 8) >> 1); return ((kk >> 3) * 4 + (c >> 5)) * 512 + ((kk & 7) * 32 + (c & 31)) * 2; }
__device__ __forceinline__ int v_rd_base(int lane) { return ((lane & 3) << 3) | (((lane >> 2) & 3) << 6) | (((lane >> 4) & 1) << 5) | (((lane >> 5) & 1) << 8); }
constexpr int v_rd_off(int d0, int ks, int half) { return d0 * 512 + ks * 4096 + half * 2048; }
template <int OFF> __device__ __forceinline__ s16x4 tr_read(int vb) {
    s16x4 r; asm volatile("ds_read_b64_tr_b16 %0, %1 offset:%2" : "=&v"(r) : "v"(vb), "i"(OFF) : "memory"); return r;
}
template <int D0> __device__ __forceinline__ void pv_one(f32x16& od, int vb, bf16x8 pa0, bf16x8 pa1, bf16x8 pa2, bf16x8 pa3) {
    const s16x4 l0 = tr_read<v_rd_off(D0, 0, 0)>(vb), h0 = tr_read<v_rd_off(D0, 0, 1)>(vb), l1 = tr_read<v_rd_off(D0, 1, 0)>(vb), h1 = tr_read<v_rd_off(D0, 1, 1)>(vb);
    const s16x4 l2 = tr_read<v_rd_off(D0, 2, 0)>(vb), h2 = tr_read<v_rd_off(D0, 2, 1)>(vb), l3 = tr_read<v_rd_off(D0, 3, 0)>(vb), h3 = tr_read<v_rd_off(D0, 3, 1)>(vb);
    asm volatile("s_waitcnt lgkmcnt(0)" ::: "memory"); SBAR();
#define PK(Lx, Hx) (bf16x8){Lx[0], Lx[1], Lx[2], Lx[3], Hx[0], Hx[1], Hx[2], Hx[3]}
    od = __builtin_amdgcn_mfma_f32_32x32x16_bf16(pa0, PK(l0, h0), od, 0, 0, 0);
    od = __builtin_amdgcn_mfma_f32_32x32x16_bf16(pa1, PK(l1, h1), od, 0, 0, 0);
    od = __builtin_amdgcn_mfma_f32_32x32x16_bf16(pa2, PK(l2, h2), od, 0, 0, 0);
    od = __builtin_amdgcn_mfma_f32_32x32x16_bf16(pa3, PK(l3, h3), od, 0, 0, 0);
#undef PK
}
__device__ __forceinline__ void pv_d0(f32x16* o, int vb, bf16x8 pa0, bf16x8 pa1, bf16x8 pa2, bf16x8 pa3) {
    pv_one<0>(o[0], vb, pa0, pa1, pa2, pa3); pv_one<1>(o[1], vb, pa0, pa1, pa2, pa3); pv_one<2>(o[2], vb, pa0, pa1, pa2, pa3); pv_one<3>(o[3], vb, pa0, pa1, pa2, pa3);
}

__device__ __forceinline__ int swap23(int k) { return (k & ~0xC) | ((k & 4) << 1) | ((k & 8) >> 1); }
__device__ __forceinline__ void attn_unit(int b, int h, int qb, const bf16_t* __restrict__ Q, const bf16_t* __restrict__ KV, const bf16_t* __restrict__ U,
                                          bf16_t* __restrict__ MIX, char* lds, LAS unsigned char* ldsl, int t_begin, int t_end, float* __restrict__ part, int wave_s) {
    const int tid = opaque_tid_w(wave_s), wid = tid >> 6, lane = tid & 63, r32 = lane & 31, hi = lane >> 5;
    const int widu = __builtin_amdgcn_readfirstlane(wid);
    char* V_lds = lds + OFF_V; char* K_lds = lds + OFF_K; char* R_lds = lds + OFF_R;
    float* ws = (float*)(lds + OFF_WS) + wid * 64; float* li_l = ws; float* al_l = ws + 32;
    float m_reg = -1e30f, l_reg = 0; f32x16 o[4] = {}; bf16x8 qr[12];
    const char* qrl = nullptr;
    const size_t tok0 = (size_t)b * L;
    __syncthreads();
    { int qrow = qb * 256 + wid * QBLK + r32; if (qrow > L - 1) qrow = L - 1;
      const bf16_t* Qw = Q + (tok0 + qrow) * QW + h * 192 + hi * 8;
#pragma unroll
      for (int d0 = 0; d0 < 12; ++d0) qr[d0] = *(const bf16x8*)(Qw + d0 * 16); }
    const char* Kh = (const char*)(KV + tok0 * KVW + h * 256); const char* Vh = Kh + 256; const char* Rh = (const char*)(U + tok0 * UW + U_KR);
    int rowK[2], colK[2], keyV[2], colV[2];
#pragma unroll
    for (int i = 0; i < 2; ++i) { const int pc = 2 * wid + i; rowK[i] = 4 * pc + (lane >> 4); colK[i] = ((lane & 15) ^ (rowK[i] & 15)) * 16;
        const int off = pc * 1024 + lane * 16, st = off >> 9; keyV[i] = swap23((st >> 2) * 8 + ((off & 511) >> 6)); colV[i] = ((st & 3) * 32 + ((off >> 4) & 3) * 8) * 2; }
    const int rowR = 8 * wid + (lane >> 3), colR = ((lane & 7) ^ ((rowR >> 1) & 7)) * 16;
    const int vb0 = (int)(uintptr_t)V_lds + v_rd_base(lane);
#define CLK(k) ((k) < L ? (k) : L - 1)
#define DMA_KR(bb, k0) do { _Pragma("unroll") for (int _i = 0; _i < 2; ++_i) \
        __builtin_amdgcn_global_load_lds((const unsigned*)(Kh + (unsigned)(CLK((k0) + rowK[_i]) * (KVW * 2) + colK[_i])), (LAS unsigned*)(ldsl + OFF_K + (bb) * SHM_K + (2 * widu + _i) * 1024), 16, 0, 0); \
        __builtin_amdgcn_global_load_lds((const unsigned*)(Rh + (unsigned)(CLK((k0) + rowR) * (UW * 2) + colR)), (LAS unsigned*)(ldsl + OFF_R + (bb) * SHM_R + widu * 1024), 16, 0, 0); } while (0)
#define DMA_V(bb, k0) do { _Pragma("unroll") for (int _i = 0; _i < 2; ++_i) \
        __builtin_amdgcn_global_load_lds((const unsigned*)(Vh + (unsigned)(CLK((k0) + keyV[_i]) * (KVW * 2) + colV[_i])), (LAS unsigned*)(ldsl + OFF_V + (bb) * SHM_V + (2 * widu + _i) * 1024), 16, 0, 0); } while (0)
#define WAITBAR() do { asm volatile("s_waitcnt vmcnt(0) lgkmcnt(0)" ::: "memory"); __builtin_amdgcn_s_barrier(); asm volatile("" ::: "memory"); } while (0)
    const int N = t_end - t_begin;
    DMA_KR(0, t_begin * KVBLK); DMA_V(0, t_begin * KVBLK); DMA_KR(1, (t_begin + 1) * KVBLK);
    WAITBAR();
    if (part && widu != 0) {
        WAITBAR();
#pragma unroll 1
        for (int j = 0; j < N; ++j) { const int bb = j & 1, jt = t_begin + j;
            if (j + 1 < N) DMA_V(bb ^ 1, (jt + 1) * KVBLK);
            if (j + 2 < N) DMA_KR(bb, (jt + 2) * KVBLK);
            WAITBAR(); }
        return;
    }
    f32x16 pn0, pn1;
    qkt(pn0, pn1, K_lds, R_lds, qr, qrl, r32, hi);
    WAITBAR();
#define ATT_BODY(MASKED) do { const int bb = j & 1, jt = t_begin + j; \
        if (j + 1 < N) DMA_V(bb ^ 1, (jt + 1) * KVBLK); \
        if (j + 2 < N) DMA_KR(bb, (jt + 2) * KVBLK); \
        f32x16 p0 = pn0, p1 = pn1; float mn, al; bf16x8 pa0, pa1, pa2, pa3; \
        if (MASKED) kmask(p0, p1, jt * KVBLK, hi); \
        qkt(pn0, pn1, K_lds + (bb ^ 1) * SHM_K, R_lds + (bb ^ 1) * SHM_R, qr, qrl, r32, hi);     \
        partialSM(p0, p1, m_reg, mn, al); \
        if (__any(al < 1.f)) { if (hi == 0) al_l[r32] = al; asm volatile("s_waitcnt lgkmcnt(0)" ::: "memory"); \
            _Pragma("unroll") for (int d = 0; d < 4; ++d) _Pragma("unroll") for (int r = 0; r < 16; ++r) o[d][r] *= al_l[crow(r, hi)]; } \
        finishSM(p0, p1, al, l_reg, pa0, pa1, pa2, pa3); SBAR(); \
        pv_d0(o, vb0 + bb * SHM_V, pa0, pa1, pa2, pa3); \
        WAITBAR(); } while (0)
    int j = 0;
#pragma unroll 1
    for (; j < N && (t_begin + j + 1) * KVBLK <= L; ++j) ATT_BODY(false);
#pragma unroll 1
    for (; j < N; ++j) ATT_BODY(true);
#undef ATT_BODY
    if (part) {
        if (wid == 0) {
#pragma unroll
            for (int r = 0; r < 16; ++r) { const int orow = crow(r, hi);
                if (orow < 16) {
#pragma unroll
                    for (int d0 = 0; d0 < 4; ++d0) part[orow * 128 + d0 * 32 + r32] = o[d0][r]; } }
            if (lane < 16) { part[2048 + lane] = m_reg; part[2064 + lane] = l_reg; }
        }
        return;
    }
    if (hi == 0) li_l[r32] = l_reg; asm volatile("s_waitcnt lgkmcnt(0)" ::: "memory");
    const int rbase = qb * 256 + wid * QBLK;
#pragma unroll
    for (int rh = 0; rh < 2; ++rh) {
        unsigned short gt[8][4];
#pragma unroll
        for (int r8 = 0; r8 < 8; ++r8) { const int r = rh * 8 + r8, prow = min(rbase + crow(r, hi), L - 1); const size_t t = tok0 + prow;
#pragma unroll
            for (int d0 = 0; d0 < 4; ++d0) gt[r8][d0] = U[t * UW + U_AG + h * 128 + d0 * 32 + r32]; }
#pragma unroll
        for (int r8 = 0; r8 < 8; ++r8) { const int r = rh * 8 + r8, orow = crow(r, hi), prow = rbase + orow;
            const float rli = __builtin_amdgcn_rcpf(li_l[orow]);
            if (prow < L) { const size_t t = tok0 + prow;
#pragma unroll
                for (int d0 = 0; d0 < 4; ++d0) { const int c = h * 128 + d0 * 32 + r32;
                    const float ov = o[d0][r] * rli * bf1(gt[r8][d0]); MIX[t * DM + 512 + c] = (bf16_t)(cvt_pk_bf16(ov, ov) & 0xffffu); } } }
    }
#undef DMA_KR
#undef DMA_V
#undef WAITBAR
#undef CLK
}
}

struct Args {
    const float* x; const float* meta; const float* norm_w; const float* w_in; const float* fourier_w; const float* pool_w; const float* pool_scale;
    const float* q_norm_w; const float* w_uq; const float* kv_norm_w; const float* w_ukv; const float* w_out; const float* final_norm_w;
    float* out; unsigned char* ws; int ph_lo, ph_hi;
};

__device__ __forceinline__ float wsrc(const Args& a, int layer, int mat, int k, int j) {
    const float* w_in = a.w_in + (size_t)layer * DM * DIN + (size_t)k * DIN;
    if (mat == 0) {
        const float nw = a.norm_w[layer * DM + k];
        if (j < 384) return w_in[1024 + j] * nw;
        if (j < 448) return w_in[1664 + rope_src(j - 384)] * nw;
        if (j < 512) return 0.f;
        if (j < 768) return w_in[1408 + j - 512] * nw;
        if (j < 1024) return w_in[256 + j - 768] * nw;
        if (j < 1280) return 0.f;
        if (j < 1536) return w_in[768 + j - 1280] * nw;
        return w_in[1728 + j - 1536] * nw;
    } else if (mat == 1) {
        return 0.f;
    } else if (mat == 2) {
        const int hh = j / 192, w = j % 192; const int col = w < 128 ? j : hh * 192 + 128 + rope_src(w - 128);
        return a.w_uq[((size_t)layer * 384 + k) * 768 + col] * a.q_norm_w[layer * 384 + k];
    } else if (mat == 3) {
        return a.w_ukv[((size_t)layer * 256 + k) * 1024 + j] * a.kv_norm_w[layer * 256 + k];
    }
    return a.w_out[((size_t)layer * 1024 + k) * 1024 + j];
}
__device__ __forceinline__ void prep_item(const Args& a, int layer, int mat, int K, bf16_t* WT, int item, int nblk, LAS float* scr, int lane) {
    const int kb = item / nblk, nb = item % nblk, k0 = 64 * kb, n0 = 32 * nb;
#pragma unroll 1
    for (int i0 = 0; i0 < 32; i0 += 8) { float tv[8];
#pragma unroll
        for (int e = 0; e < 8; ++e) tv[e] = wsrc(a, layer, mat, k0 + 2 * (i0 + e) + (lane >> 5), n0 + (lane & 31));
#pragma unroll
        for (int e = 0; e < 8; ++e) scr[(2 * (i0 + e) + (lane >> 5)) * 33 + (lane & 31)] = tv[e]; }
    asm volatile("s_waitcnt lgkmcnt(0)" ::: "memory");
    const int c = lane & 7;
#pragma unroll
    for (int jx = 0; jx < 4; ++jx) { const int n = (lane >> 3) + 8 * jx; const LAS float* s = scr + (8 * c) * 33 + n;
        u32x4 o; o.x = cvt_pk_bf16(s[0 * 33], s[1 * 33]); o.y = cvt_pk_bf16(s[2 * 33], s[3 * 33]); o.z = cvt_pk_bf16(s[4 * 33], s[5 * 33]); o.w = cvt_pk_bf16(s[6 * 33], s[7 * 33]);
        *(u32x4*)(WT + (size_t)(n0 + n) * K + k0 + 8 * c) = o; }
    asm volatile("s_waitcnt lgkmcnt(0)" ::: "memory");
}


__device__ __forceinline__ void fold_item(const float* __restrict__ w_in_l, const float* __restrict__ nw, const float* __restrict__ F, float fscale, int base, bf16_t* WT, int row0, int k0, int lane) {
    float Freg[64];
#pragma unroll
    for (int c = 0; c < 64; ++c) Freg[c] = F[c * 64 + lane] * fscale;
#pragma unroll 1
    for (int kk0 = 0; kk0 < 64; kk0 += 8) {
        float av[8], acc[8];
#pragma unroll
        for (int e = 0; e < 8; ++e) { av[e] = w_in_l[(size_t)(k0 + kk0 + e) * DIN + base + lane]; acc[e] = 0.f; }
#pragma unroll
        for (int c = 0; c < 64; ++c) { const float f = Freg[c];
#pragma unroll
            for (int e = 0; e < 8; ++e) acc[e] += __uint_as_float((unsigned)__builtin_amdgcn_readlane((int)__float_as_uint(av[e]), c)) * f; }
#pragma unroll
        for (int e = 0; e < 8; ++e) acc[e] *= nw[k0 + kk0 + e];
        u32x4 o; o.x = cvt_pk_bf16(acc[0], acc[1]); o.y = cvt_pk_bf16(acc[2], acc[3]); o.z = cvt_pk_bf16(acc[4], acc[5]); o.w = cvt_pk_bf16(acc[6], acc[7]);
        *(u32x4*)(WT + (size_t)(row0 + lane) * 1024 + k0 + kk0) = o;
    }
}


#define XB_TMO      128
#define XB_XCNT(j)  (256  + 64 * (j))
#define XB_XSUB(j)  (1280 + 64 * (j))
#define XB_XGEN(j)  (2304 + 64 * (j))
#define XB_TOP      3328
#define XB_TOPGEN   3392
#define XCD_BAR_WORDS 3456
#define XB_SPIN_CAP (1u << 18)
__device__ __forceinline__ unsigned xb_ld(unsigned* p)              { return __hip_atomic_load(p, __ATOMIC_RELAXED, __HIP_MEMORY_SCOPE_AGENT); }
__device__ __forceinline__ unsigned xb_add(unsigned* p, unsigned v) { return __hip_atomic_fetch_add(p, v, __ATOMIC_RELAXED, __HIP_MEMORY_SCOPE_AGENT); }
__device__ __forceinline__ unsigned xb_xcc_id() { return (unsigned)__builtin_amdgcn_s_getreg((3 << 11) | 20) & 0xFu; }
#define XB_SPIN(cond, bar) do { unsigned _sp = 0; while (cond) { __builtin_amdgcn_s_sleep(1); \
    if ((++_sp & 255u) == 0u) { if (xb_ld(&(bar)[XB_TMO])) break; if (_sp > XB_SPIN_CAP) { atomicAdd(&(bar)[XB_TMO], 1u); break; } } } } while (0)
__device__ __forceinline__ void xcd_barrier_complete(unsigned* bar, unsigned x, unsigned& nloc, unsigned& nx) {
    const unsigned G = gridDim.x;
    unsigned sum, cnt, mine, sp = 0u;
    for (;;) {
        sum = 0u; cnt = 0u; mine = 0u;
#pragma unroll
        for (unsigned j = 0; j < 16; ++j) { const unsigned c = xb_ld(&bar[XB_XCNT(j)]); sum += c; cnt += (c > 0u) ? 1u : 0u; mine = (j == x) ? c : mine; }
        if (sum == G) break;
        __builtin_amdgcn_s_sleep(1);
        if ((++sp & 255u) == 0u) { if (xb_ld(&bar[XB_TMO])) break; if (sp > XB_SPIN_CAP) { atomicAdd(&bar[XB_TMO], 1u); break; } }
    }
    nloc = mine > 0u ? mine : 1u; nx = cnt > 0u ? cnt : 1u;
}
__device__ __forceinline__ void xcd_barrier(unsigned* bar, volatile LAS unsigned* st, bool leader) {
    asm volatile("s_waitcnt vmcnt(0)" ::: "memory");
    __syncthreads();
    if (leader) {
        const unsigned x = xb_xcc_id();
        __builtin_amdgcn_s_waitcnt(0);
        unsigned nloc = st[0], nx = st[1];
        if (nloc == 0u) { xcd_barrier_complete(bar, x, nloc, nx); st[0] = nloc; st[1] = nx; }
        const unsigned old = xb_add(&bar[XB_XSUB(x)], 1u);
        const unsigned gen = old / nloc;
        if (old + 1u == (gen + 1u) * nloc) {
            __builtin_amdgcn_fence(__ATOMIC_RELEASE, "agent");
            asm volatile("s_waitcnt vmcnt(0)" ::: "memory");
            const unsigned og = xb_add(&bar[XB_TOP], 1u);
            const unsigned tg = og / nx;
            if (og + 1u == (tg + 1u) * nx) xb_add(&bar[XB_TOPGEN], 1u);
            else XB_SPIN(xb_ld(&bar[XB_TOPGEN]) == tg, bar);
            __builtin_amdgcn_fence(__ATOMIC_ACQUIRE, "agent");
            xb_add(&bar[XB_XGEN(x)], 1u);
            asm volatile("s_waitcnt vmcnt(0)" ::: "memory");
        } else {
            XB_SPIN(xb_ld(&bar[XB_XGEN(x)]) == gen, bar);
            __builtin_amdgcn_fence(__ATOMIC_ACQUIRE, "agent");
            asm volatile("s_waitcnt vmcnt(0)" ::: "memory");
        }
    }
    __syncthreads();
}

#ifndef PHMASK
#define PHMASK 0xFF
#endif
#define PHM(k) ((PHMASK >> (k)) & 1)
#ifndef Q3
#define Q3 15
#endif
__global__ void __launch_bounds__(512) hymba_fwd(Args a) {
    extern __shared__ __attribute__((aligned(16))) unsigned char lds[];
    cg::grid_group grid = cg::this_grid();
    const int wave_s = __builtin_amdgcn_readfirstlane((int)threadIdx.x >> 6);
    if (threadIdx.x == 0) { volatile LAS unsigned* xst0 = (volatile LAS unsigned*)((LAS unsigned char*)lds + 135168); xst0[0] = 0u; xst0[1] = 0u;
        (void)xb_add(&((unsigned*)(a.ws + WS_BAR))[XB_XCNT(xb_xcc_id())], 1u); }
    __syncthreads();
#pragma unroll 1
    for (int ph = a.ph_lo; ph < a.ph_hi; ++ph) {
    size_t wz = 0; asm volatile("" : "+s"(wz));
    unsigned char* ws = a.ws + wz;
    const int tid = opaque_tid_w(wave_s), lane = tid & 63, wave = __builtin_amdgcn_readfirstlane(tid >> 6);
    int G = gridDim.x, bx = blockIdx.x; asm volatile("" : "+s"(G), "+s"(bx));
    const int vcu = (G % 8 == 0) ? (bx % 8) * (G / 8) + bx / 8 : bx;
    const int gw = vcu * 8 + wave, NGW = G * 8;
    bf16_t* H = (bf16_t*)(ws + WS_H); float* RH = (float*)(ws + WS_RH); bf16_t* MIX = (bf16_t*)(ws + WS_HN); bf16_t* U = (bf16_t*)(ws + WS_U);
    bf16_t* XT = (bf16_t*)(ws + WS_XT); bf16_t* DFT = (bf16_t*)(ws + WS_DFT); bf16_t* Qb = (bf16_t*)(ws + WS_Q); bf16_t* KVb = (bf16_t*)(ws + WS_KV);
    bf16_t* WN = (bf16_t*)(ws + WS_WN); bf16_t* WF = (bf16_t*)(ws + WS_WF); bf16_t* WQ = (bf16_t*)(ws + WS_WQ); bf16_t* WKV = (bf16_t*)(ws + WS_WKV); bf16_t* WO = (bf16_t*)(ws + WS_WO);
    float* RQ = (float*)(ws + WS_RQ); float* RKV = (float*)(ws + WS_RKV); float* COS = (float*)(ws + WS_COS); float* SIN = (float*)(ws + WS_SIN);
    float* CWF = (float*)(ws + WS_CWF); float* SWF = (float*)(ws + WS_SWF);
    LAS unsigned char* ldsl = (LAS unsigned char*)lds;
    {
        if (ph == 0 && PHM(6)) {
            float* tabc = (float*)lds; float* tabs = tabc + L;
            for (int m = tid; m < L; m += 512) { float s, c; sincospif(2.0f * (float)m / (float)L, &s, &c); tabc[m] = c; tabs[m] = s; }
            __syncthreads();
            for (int k = bx; k < L; k += G) {
                bf16_t* row = DFT + (size_t)k * KF;
                for (int ch = tid; ch < KF / 8; ch += 512) {
                    const int c0 = ch * 8, hs = c0 >= LF, l0 = c0 - hs * LF;
                    int idx = (int)(((long)k * l0) % L); float v[8];
#pragma unroll
                    for (int e = 0; e < 8; ++e) { const bool ok = (l0 + e) <= LH; v[e] = ok ? (hs ? -tabs[idx] : tabc[idx]) : 0.f; idx += k; if (idx >= L) idx -= L; }
                    u32x4 o; o.x = cvt_pk_bf16(v[0], v[1]); o.y = cvt_pk_bf16(v[2], v[3]); o.z = cvt_pk_bf16(v[4], v[5]); o.w = cvt_pk_bf16(v[6], v[7]);
                    *(u32x4*)(row + c0) = o;
                }
            }
            for (int i = bx * 512 + tid; i < L * 32; i += G * 512) { const int pos = i >> 5, ii = i & 31;
                const float inv = 1.0f / powf(10000.0f, (float)(2 * ii) / 64.0f); const float ang = (float)pos * inv; float s, c; sincosf(ang, &s, &c); COS[i] = c; SIN[i] = s; }
            for (int i = bx * 512 + tid; i < DEPTH * 4 * 64 * 64; i += G * 512) { const int d = i & 63, c = (i >> 6) & 63, lh = i >> 12;
                const float* Wf = a.fourier_w + (size_t)lh * 4096 + d; float sc_ = 0.f, ss_ = 0.f;
                for (int e = 0; e < 64; ++e) { float s, cc; sincospif((float)((c * e) & 63) / 32.0f, &s, &cc); const float w = Wf[e * 64]; sc_ += cc * w; ss_ += s * w; }
                const float nrm = rsqrtf((float)L * 64.0f); CWF[i] = sc_ * nrm; SWF[i] = ss_ * nrm; }
            for (int i = bx * 512 + tid; i < 4096 * 2 * 14; i += G * 512) { const int ch = i % 14, hs = (i / 14) & 1, r = i / 28;
                const unsigned z = __float_as_uint(opaque_zero()); *(u32x4*)(XT + (size_t)r * KD + hs * LP + L + ch * 8) = (u32x4){z, z, z, z}; }
            __syncthreads();
        } else if (ph == 1 + 6 * DEPTH && PHM(7)) {
            for (int r = gw; r < NB * SEQ; r += NGW) { const int b = r >> 12, s = r & 4095;
                const u32x4* xr = (const u32x4*)(H + ((size_t)b * L + NMETA + s) * DM) + lane; const u32x4 x0 = xr[0], x1 = xr[64];
                float v[16]; v[0] = bf_lo(x0.x); v[1] = bf_hi(x0.x); v[2] = bf_lo(x0.y); v[3] = bf_hi(x0.y); v[4] = bf_lo(x0.z); v[5] = bf_hi(x0.z); v[6] = bf_lo(x0.w); v[7] = bf_hi(x0.w);
                v[8] = bf_lo(x1.x); v[9] = bf_hi(x1.x); v[10] = bf_lo(x1.y); v[11] = bf_hi(x1.y); v[12] = bf_lo(x1.z); v[13] = bf_hi(x1.z); v[14] = bf_lo(x1.w); v[15] = bf_hi(x1.w);
                float ss = 0.f;
#pragma unroll
                for (int e = 0; e < 16; ++e) ss += v[e] * v[e];
                const float rstd = rsqrtf(wave_sum(ss) * (1.f / DM) + NORM_EPS);
                float* orow = a.out + (size_t)r * DM; const float* fw = a.final_norm_w;
#pragma unroll
                for (int hlf = 0; hlf < 2; ++hlf) { const int c0 = hlf * 512 + lane * 8; const f32x4 w0 = *(const f32x4*)(fw + c0), w1 = *(const f32x4*)(fw + c0 + 4);
                    f32x4 o0 = {v[hlf * 8 + 0] * rstd * w0[0], v[hlf * 8 + 1] * rstd * w0[1], v[hlf * 8 + 2] * rstd * w0[2], v[hlf * 8 + 3] * rstd * w0[3]};
                    f32x4 o1 = {v[hlf * 8 + 4] * rstd * w1[0], v[hlf * 8 + 5] * rstd * w1[1], v[hlf * 8 + 6] * rstd * w1[2], v[hlf * 8 + 7] * rstd * w1[3]};
                    *(f32x4*)(orow + c0) = o0; *(f32x4*)(orow + c0 + 4) = o1; } }
        } else if (ph > 0 && ph < 1 + 6 * DEPTH) {
            const int layer = (ph - 1) / 6, kind = (ph - 1) % 6;
            if (kind == 0 && PHM(0)) {
                LAS float* scr = (LAS float*)(ldsl + wave * 8448);
                constexpr int I0 = 16 * 64, IF = 192, I2 = 6 * 24, I3 = 4 * 32, I4 = 16 * 32;
                for (int it = gw; it < IF + I0 + I2 + I3 + I4; it += NGW) { int r = it;
                    if (r < IF) {
                        const float* w_in_l = a.w_in + (size_t)layer * DM * DIN; const float* nw = a.norm_w + layer * DM; const int kb = r & 15, part = r >> 4;
                        if (part < 4) fold_item(w_in_l, nw, a.pool_w + (size_t)(layer * 4 + part) * 4096, a.pool_scale[layer * 256 + part * 64 + lane], 512 + part * 64, WN, 1024 + part * 64, kb * 64, lane);
                        else { const int pp = part - 4, hh = pp & 3, sn = pp >> 2;
                            fold_item(w_in_l, nw, (sn ? SWF : CWF) + (size_t)(layer * 4 + hh) * 4096, 1.f, hh * 64, WF, sn * 256 + hh * 64, kb * 64, lane); }
                        continue; } r -= IF;
                    if (r < I0) { if ((r & 63) < 32 || (r & 63) >= 40) prep_item(a, layer, 0, 1024, WN, r, 64, scr, lane); continue; } r -= I0;
                    if (r < I2) { prep_item(a, layer, 2, 384, WQ, r, 24, scr, lane); continue; } r -= I2;
                    if (r < I3) { prep_item(a, layer, 3, 256, WKV, r, 32, scr, lane); continue; } r -= I3;
                    prep_item(a, layer, 4, 1024, WO, r, 32, scr, lane); }
                if (layer == 0) {
                    for (int r0 = gw * 4; r0 < MTOK; r0 += NGW * 4) {
                        f32x4 v[4][4]; float ss[4];
#pragma unroll
                        for (int q = 0; q < 4; ++q) { const int r = r0 + q; const int b = r / L, l = r - b * L;
                            const float* src = l < NMETA ? a.meta + (size_t)l * DM : a.x + ((size_t)b * SEQ + l - NMETA) * DM;
                            const f32x4* xr = (const f32x4*)src + lane;
#pragma unroll
                            for (int j = 0; j < 4; ++j) v[q][j] = xr[64 * j]; }
#pragma unroll
                        for (int q = 0; q < 4; ++q) { float t = 0.f;
#pragma unroll
                            for (int j = 0; j < 4; ++j) t += v[q][j].x * v[q][j].x + v[q][j].y * v[q][j].y + v[q][j].z * v[q][j].z + v[q][j].w * v[q][j].w;
                            ss[q] = t; }
#pragma unroll
                        for (int o = 1; o < 64; o <<= 1) {
#pragma unroll
                            for (int q = 0; q < 4; ++q) ss[q] += __uint_as_float((unsigned)__builtin_amdgcn_ds_bpermute((lane ^ o) << 2, (int)__float_as_uint(ss[q]))); }
#pragma unroll
                        for (int q = 0; q < 4; ++q) { const int r = r0 + q;
                            if (lane == 0) RH[r] = rsqrtf(ss[q] * (1.f / DM) + NORM_EPS);
                            u32x2* o8 = (u32x2*)(H + (size_t)r * DM) + lane;
#pragma unroll
                            for (int j = 0; j < 4; ++j) { u32x2 w; w.x = cvt_pk_bf16(v[q][j].x, v[q][j].y); w.y = cvt_pk_bf16(v[q][j].z, v[q][j].w); o8[64 * j] = w; } }
                    }
                } else {
                    for (int r0 = gw * 8; r0 < MTOK; r0 += NGW * 8) {
                        u32x4 v[8][2]; float ss[8];
#pragma unroll
                        for (int q = 0; q < 8; ++q) { const u32x4* xr = (const u32x4*)(H + (size_t)(r0 + q) * DM) + lane; v[q][0] = xr[0]; v[q][1] = xr[64]; }
#pragma unroll
                        for (int q = 0; q < 8; ++q) { float t = 0.f;
#pragma unroll
                            for (int j = 0; j < 2; ++j) { const u32x4 x = v[q][j]; float e;
                                e = bf_lo(x.x); t += e * e; e = bf_hi(x.x); t += e * e; e = bf_lo(x.y); t += e * e; e = bf_hi(x.y); t += e * e;
                                e = bf_lo(x.z); t += e * e; e = bf_hi(x.z); t += e * e; e = bf_lo(x.w); t += e * e; e = bf_hi(x.w); t += e * e; }
                            ss[q] = t; }
#pragma unroll
                        for (int o = 1; o < 64; o <<= 1) {
#pragma unroll
                            for (int q = 0; q < 8; ++q) ss[q] += __uint_as_float((unsigned)__builtin_amdgcn_ds_bpermute((lane ^ o) << 2, (int)__float_as_uint(ss[q]))); }
                        if (lane < 8) { float sv = ss[0];
#pragma unroll
                            for (int q = 1; q < 8; ++q) sv = (lane == q) ? ss[q] : sv;
                            RH[r0 + lane] = rsqrtf(sv * (1.f / DM) + NORM_EPS); }
                    }
                }
            } else if ((kind == 1 || kind == 3 || kind == 5) && PHM(1)) {
                const int j0 = kind == 1 ? 0 : (kind == 3 ? 2 : 5), j1 = kind == 1 ? 2 : (kind == 3 ? 5 : 6);
                if (kind == 5) {
                    const float* PART = (const float*)(ws + WS_PART);
                    for (int gi = bx * 512 + tid; gi < 64 * 16 * 128; gi += G * 512) { const int col = gi & 127, row = (gi >> 7) & 15, bh = gi >> 11; constexpr float C = att::SCALE * 1.4426950408889634f;
                        const float* p0 = PART + (size_t)(bh * 4) * PART_STRIDE; float m = -1e30f;
#pragma unroll
                        for (int q = 0; q < 4; ++q) m = fmaxf(m, p0[q * PART_STRIDE + 2048 + row]);
                        float lsum = 0.f, osum = 0.f;
#pragma unroll
                        for (int q = 0; q < 4; ++q) { const float w = __builtin_amdgcn_exp2f((p0[q * PART_STRIDE + 2048 + row] - m) * C); lsum += p0[q * PART_STRIDE + 2064 + row] * w; osum += p0[q * PART_STRIDE + row * 128 + col] * w; }
                        const size_t t = (size_t)(bh >> 2) * L + 4096 + row; const int c = (bh & 3) * 128 + col;
                        const float ov = osum / lsum * bf1(U[t * UW + U_AG + c]); MIX[t * DM + 512 + c] = (bf16_t)(cvt_pk_bf16(ov, ov) & 0xffffu); }
                    asm volatile("s_waitcnt vmcnt(0) lgkmcnt(0)" ::: "memory");
                    xcd_barrier((unsigned*)(ws + WS_BAR), (volatile LAS unsigned*)(ldsl + 135168), tid == 0);
                }
#pragma unroll 1
                for (int jb = j0; jb < j1; ++jb) {
                    pg8::Gemm g;
                    if (jb == 0)      g = pg8::Gemm{H, WN, MTOK, UW, DM, DM, DM};
                    else if (jb == 1) g = pg8::Gemm{WF, H, 512, MTOK, DM, DM, DM};
                    else if (jb == 2) g = pg8::Gemm{DFT, XT, 4096, 4096, KF, KF, KD};
                    else if (jb == 3) g = pg8::Gemm{U + U_CQ, WQ, MTOK, QW, 384, UW, 384};
                    else if (jb == 4) g = pg8::Gemm{U + U_CKV, WKV, MTOK, KVW, 256, UW, 256};
                    else              g = pg8::Gemm{MIX, WO, MTOK, DM, DM, DM, DM};
                    const int rot = (jb == 1 || jb == 4) ? 8 : (jb == 3 ? 16 : 0);
                    pg8::StaticOrder S; S.init(g.M, g.N, G, (bx + G - rot) % G); EpiAll E{jb, ws};
                    pg8::gemm_phase<EpiAll>(ldsl, g, S, E, wave_s);
                    if (jb == 2) {
                for (int it = vcu; it < 256; it += G) {
                    const int fr = lane & 15, fq = lane >> 4;
                    const bf16_t* ap = DFT + (size_t)(4096 + fr) * KF + wave * 544 + fq * 8;
                    const bf16_t* bp = XT + (size_t)(it * 16 + fr) * KD + wave * 544 + fq * 8;
                    const float z0 = opaque_zero(); f32x4 c = {z0, z0, z0, z0};
#pragma unroll
                    for (int s0 = 0; s0 < 18; s0 += 6) { bf16x8 av[6], bv[6];
#pragma unroll
                        for (int e = 0; e < 6; ++e) if (s0 + e < 17) { av[e] = *(const bf16x8*)(ap + (s0 + e) * 32); bv[e] = *(const bf16x8*)(bp + (s0 + e) * 32); }
#pragma unroll
                        for (int e = 0; e < 6; ++e) if (s0 + e < 17) c = __builtin_amdgcn_mfma_f32_16x16x32_bf16(av[e], bv[e], c, 0, 0, 0); }
                    float* red = (float*)lds;
                    __syncthreads();
#pragma unroll
                    for (int j = 0; j < 4; ++j) red[wave * 256 + (fq * 4 + j) * 16 + fr] = c[j];
                    __syncthreads();
                    if (tid < 256) { float s = 0.f;
#pragma unroll
                        for (int w = 0; w < 8; ++w) s += red[w * 256 + tid];
                        const int kr = tid >> 4, cc = it * 16 + (tid & 15), b = cc >> 8, n = cc & 255; const size_t tok = (size_t)b * L + 4096 + kr;
                        const float gt = bf1(U[tok * UW + U_FG + n]);
                        { const float sv = s * gt; MIX[tok * DM + n] = (bf16_t)(cvt_pk_bf16(sv, sv) & 0xffffu); } }
                    __syncthreads();
                }
                    }
                }
            } else if (kind == 2 && PHM(2)) {
                for (int pr = gw; pr < MTOK / 2; pr += NGW) {
                    const int t0 = pr * 2;
#pragma unroll
                    for (int q = 0; q < 2; ++q) { const bf16_t* row = U + (size_t)(t0 + q) * UW;
                        const u32x4 x = *(const u32x4*)(row + lane * 8); float sq = 0.f, sk = 0.f;
                        if (lane < 48) { float e; e = bf_lo(x.x); sq += e * e; e = bf_hi(x.x); sq += e * e; e = bf_lo(x.y); sq += e * e; e = bf_hi(x.y); sq += e * e;
                                         e = bf_lo(x.z); sq += e * e; e = bf_hi(x.z); sq += e * e; e = bf_lo(x.w); sq += e * e; e = bf_hi(x.w); sq += e * e; }
                        if (lane < 32) { const u32x4 y = *(const u32x4*)(row + U_CKV + lane * 8); float e;
                                         e = bf_lo(y.x); sk += e * e; e = bf_hi(y.x); sk += e * e; e = bf_lo(y.y); sk += e * e; e = bf_hi(y.y); sk += e * e;
                                         e = bf_lo(y.z); sk += e * e; e = bf_hi(y.z); sk += e * e; e = bf_lo(y.w); sk += e * e; e = bf_hi(y.w); sk += e * e; }
                        sq = wave_sum(sq); sk = wave_sum(sk);
                        if (lane == 0) { RQ[t0 + q] = rsqrtf(sq * (1.f / 384.f) + NORM_EPS); RKV[t0 + q] = rsqrtf(sk * (1.f / 256.f) + NORM_EPS); } }
                    const int t = t0 + (lane >> 5), cgp = lane & 31, b = t / L, l = t - b * L, gI = cgp >> 3, half = 1 << gI;
                    const int lo = max(l - half, 0), hi = min(l + half, L);
                    float s[8] = {0.f, 0.f, 0.f, 0.f, 0.f, 0.f, 0.f, 0.f};
                    const bf16_t* base = U + (size_t)b * L * UW + U_PP + cgp * 8;
                    u32x4 xw[16];
#pragma unroll
                    for (int i = 0; i < 16; ++i) { int tt = l - 8 + i; tt = tt < 0 ? 0 : (tt > L - 1 ? L - 1 : tt); xw[i] = *(const u32x4*)(base + (size_t)tt * UW); }
#pragma unroll
                    for (int i = 0; i < 16; ++i) { const int tt = l - 8 + i; const float wgt = (tt >= lo && tt < hi) ? 1.f : 0.f; const u32x4 x = xw[i];
                        s[0] += wgt * bf_lo(x.x); s[1] += wgt * bf_hi(x.x); s[2] += wgt * bf_lo(x.y); s[3] += wgt * bf_hi(x.y); s[4] += wgt * bf_lo(x.z); s[5] += wgt * bf_hi(x.z); s[6] += wgt * bf_lo(x.w); s[7] += wgt * bf_hi(x.w); }
                    const float ic = 1.f / (float)(hi - lo);
                    const u32x4 xs = *(const u32x4*)(base + (size_t)l * UW); const u32x4 gt = *(const u32x4*)(U + (size_t)t * UW + U_PG + cgp * 8);
                    float y[8];
                    y[0] = (s[0] * ic - bf_lo(xs.x)) * bf_lo(gt.x); y[1] = (s[1] * ic - bf_hi(xs.x)) * bf_hi(gt.x);
                    y[2] = (s[2] * ic - bf_lo(xs.y)) * bf_lo(gt.y); y[3] = (s[3] * ic - bf_hi(xs.y)) * bf_hi(gt.y);
                    y[4] = (s[4] * ic - bf_lo(xs.z)) * bf_lo(gt.z); y[5] = (s[5] * ic - bf_hi(xs.z)) * bf_hi(gt.z);
                    y[6] = (s[6] * ic - bf_lo(xs.w)) * bf_lo(gt.w); y[7] = (s[7] * ic - bf_hi(xs.w)) * bf_hi(gt.w);
                    u32x4 o; o.x = cvt_pk_bf16(y[0], y[1]); o.y = cvt_pk_bf16(y[2], y[3]); o.z = cvt_pk_bf16(y[4], y[5]); o.w = cvt_pk_bf16(y[6], y[7]);
                    *(u32x4*)(MIX + (size_t)t * DM + 256 + cgp * 8) = o;
                }
                { bf16_t* rowl = (bf16_t*)(lds + wave * 16896);
                  for (int r = gw; r < 4096; r += NGW) { bf16_t* xr = XT + (size_t)r * KD;
                      { u32x4 tmpv[17];
#pragma unroll
                        for (int it = 0; it < 17; ++it) { const int c = lane + 64 * it; if (c < KD / 8) tmpv[it] = *(const u32x4*)(xr + c * 8); }
#pragma unroll
                        for (int it = 0; it < 17; ++it) { const int c = lane + 64 * it; if (c < KD / 8) *(u32x4*)(rowl + c * 8) = tmpv[it]; } }
                      asm volatile("s_waitcnt vmcnt(0) lgkmcnt(0)" ::: "memory");
                      for (int c = lane; c < KF / 8; c += 64) { const int c0 = c * 8, hs = c0 >= LF, l0 = c0 - hs * LF; const bf16_t* hb = rowl + hs * LP; float v[8];
#pragma unroll
                          for (int e = 0; e < 8; ++e) { const int l = l0 + e; float x = 0.f;
                              if (l <= LH) { x = bf1(hb[l]); if (l > 0 && l < LH) { const float y = bf1(hb[L - l]); x = hs ? x - y : x + y; } else if (hs) x = 0.f; }
                              v[e] = x; }
                          u32x4 o; o.x = cvt_pk_bf16(v[0], v[1]); o.y = cvt_pk_bf16(v[2], v[3]); o.z = cvt_pk_bf16(v[4], v[5]); o.w = cvt_pk_bf16(v[6], v[7]);
                          *(u32x4*)(xr + c0) = o; }
                      asm volatile("s_waitcnt vmcnt(0) lgkmcnt(0)" ::: "memory"); } }
            } else if (kind == 4 && PHM(4)) {
                float* PART = (float*)(ws + WS_PART);
                for (int i = 0;; ++i) { const int uidx = i * G + vcu; if (uidx >= 1024 + 256) break;
                    if (uidx < 1024) { const int bh = uidx >> 4, qb = uidx & 15; att::attn_unit(bh >> 2, bh & 3, qb, Qb, KVb, U, MIX, (char*)lds, ldsl, 0, att::NT, nullptr, wave_s); }
                    else { const int v = uidx - 1024, bh = v >> 2, q = v & 3;
                        const int tb = q < 2 ? 17 * q : 34 + 16 * (q - 2), te = q < 2 ? tb + 17 : (q == 2 ? tb + 16 : att::NT);
                        att::attn_unit(bh >> 2, bh & 3, 16, Qb, KVb, U, MIX, (char*)lds, ldsl, tb, te, PART + (size_t)v * PART_STRIDE, wave_s); } }
                __syncthreads();
            }
        }
    }
        asm volatile("s_waitcnt vmcnt(0) lgkmcnt(0)" ::: "memory");
        if (ph + 1 < a.ph_hi) {
            if (ph == a.ph_lo) grid.sync();
            else xcd_barrier((unsigned*)(ws + WS_BAR), (volatile LAS unsigned*)(ldsl + 135168), tid == 0);
        }
    }
}


#ifndef N_LAUNCH_SPLIT
#define N_LAUNCH_SPLIT 0
#endif
extern "C" void kernel_launch(void* const* d_in, const int* in_sizes, int n_in, void* d_out, int out_size, void* d_ws, size_t ws_size, hipStream_t stream) {
    static int grid = 0;
    if (grid == 0) {
        if (n_in != 13 || in_sizes[0] != NB * SEQ * DM || out_size != NB * SEQ * DM || ws_size < WS_END + 256) {
            fprintf(stderr, "kernel_launch: shape/workspace mismatch: n_in %d in0 %d out %d ws %zu (need %zu)\n", n_in, n_in > 0 ? in_sizes[0] : -1, out_size, ws_size, (size_t)WS_END); grid = -1; return; }
        int dev = 0, cus = 0, per_cu = 0;
        hipGetDevice(&dev); hipDeviceGetAttribute(&cus, hipDeviceAttributeMultiprocessorCount, dev);
        if (hipFuncSetAttribute((const void*)hymba_fwd, hipFuncAttributeMaxDynamicSharedMemorySize, LDS_BYTES) != hipSuccess) { fprintf(stderr, "kernel_launch: hipFuncSetAttribute failed\n"); grid = -1; return; }
        if (hipOccupancyMaxActiveBlocksPerMultiprocessor(&per_cu, (const void*)hymba_fwd, 512, LDS_BYTES) != hipSuccess || per_cu < 1) { fprintf(stderr, "kernel_launch: occupancy query gave %d\n", per_cu); per_cu = 1; }
        (void)hipGetLastError();
        grid = cus;
    }
    if (grid < 0) return;
    Args a{};
    a.x = (const float*)d_in[0]; a.meta = (const float*)d_in[1]; a.norm_w = (const float*)d_in[2]; a.w_in = (const float*)d_in[3]; a.fourier_w = (const float*)d_in[4];
    a.pool_w = (const float*)d_in[5]; a.pool_scale = (const float*)d_in[6]; a.q_norm_w = (const float*)d_in[7]; a.w_uq = (const float*)d_in[8]; a.kv_norm_w = (const float*)d_in[9];
    a.w_ukv = (const float*)d_in[10]; a.w_out = (const float*)d_in[11]; a.final_norm_w = (const float*)d_in[12];
    a.out = (float*)d_out; a.ws = (unsigned char*)d_ws;
    constexpr int NPH = 2 + 6 * DEPTH;
#if N_LAUNCH_SPLIT
    for (int p = 0; p < NPH; ++p) { a.ph_lo = p; a.ph_hi = p + 1; void* args[] = {&a};
        hipError_t e = hipLaunchCooperativeKernel((void*)hymba_fwd, dim3(grid), dim3(512), args, LDS_BYTES, stream);
        if (e != hipSuccess) { fprintf(stderr, "cooperative launch failed: %s\n", hipGetErrorString(e)); break; } }
#else
    (void)hipMemsetAsync((char*)d_ws + WS_BAR, 0, (size_t)XCD_BAR_WORDS * 4, stream);
    a.ph_lo = 0; a.ph_hi = NPH; void* args[] = {&a};
    hipError_t e = hipLaunchCooperativeKernel((void*)hymba_fwd, dim3(grid), dim3(512), args, LDS_BYTES, stream);
    if (e != hipSuccess) fprintf(stderr, "cooperative launch failed: %s (grid %d)\n", hipGetErrorString(e), grid);
#endif
}
```
